# Optimizing an MI355X kernel written in HIP

```python
import math
import jax, jax.numpy as jnp
from jax import lax
import numpy as np

D_MODEL = 1024
BATCH = 4
SEQ = 8192
DEPTH = 2

N_MIXERS = 2
EPS = 1e-6
ATTN_HEADS = 16
ATTN_KV_HEADS = 4
ATTN_HEAD_DIM = D_MODEL // ATTN_HEADS
ATTN_GROUP = ATTN_HEADS // ATTN_KV_HEADS
WINDOW = 128
BLOCK = 128
ROPE_THETA = 500000.0
ROPE_DIM = ATTN_HEAD_DIM // 4
Q_W = ATTN_HEADS * ATTN_HEAD_DIM
KV_W = ATTN_KV_HEADS * ATTN_HEAD_DIM
MEM_LEN = 256
MEM_HEADS = 4
MEM_HEAD_DIM = 128
MEM_W = MEM_HEADS * MEM_HEAD_DIM
LRU_WIDTH = D_MODEL
LRU_BLOCKS = 8
LRU_BLOCK_DIM = LRU_WIDTH // LRU_BLOCKS
LRU_C = 8.0
CONV_WIDTH = 4
CONV_LEFT = (CONV_WIDTH - 1) // 2
ATTN_IN_W = Q_W + 2 * KV_W + MEM_W
LRU_IN_W = 2 * LRU_WIDTH + MEM_W
MIX_OUT_W = Q_W + MEM_W
D_FF = 4 * D_MODEL
NEG = -1e30

kernel_name = "hybrid_window_gqa_rglru_memxattn_encoder"


def rms_norm(x, g):
    xf = x.astype(jnp.float32)
    y = xf * lax.rsqrt(jnp.mean(xf * xf, axis=-1, keepdims=True) + EPS) * g.astype(jnp.float32)
    return y.astype(x.dtype)


def partial_rotary(t, positions):
    half = ROPE_DIM // 2
    inv_freq = ROPE_THETA ** (-2.0 * jnp.arange(half, dtype=jnp.float32) / ROPE_DIM)
    ang = positions.astype(jnp.float32)[..., None] * inv_freq
    cos = jnp.cos(ang)[:, :, None, :]
    sin = jnp.sin(ang)[:, :, None, :]
    tr = t[..., :ROPE_DIM].astype(jnp.float32)
    t1, t2 = tr[..., :half], tr[..., half:]
    rot = jnp.concatenate([t1 * cos - t2 * sin, t2 * cos + t1 * sin], axis=-1)
    return jnp.concatenate([rot.astype(t.dtype), t[..., ROPE_DIM:]], axis=-1)


def window_gqa(q, k, v, sinks):
    B, S = q.shape[0], q.shape[1]
    nb = S // BLOCK
    qb = q.reshape(B, nb, BLOCK, ATTN_KV_HEADS, ATTN_GROUP, ATTN_HEAD_DIM)
    pad = ((0, 0), (BLOCK, BLOCK), (0, 0), (0, 0))

    def bands(t):
        tb = jnp.pad(t, pad).reshape(B, nb + 2, BLOCK, ATTN_KV_HEADS, ATTN_HEAD_DIM)
        return jnp.concatenate([tb[:, :nb], tb[:, 1:nb + 1], tb[:, 2:]], axis=2)

    kb, vb = bands(k), bands(v)
    scores = jnp.einsum('bnqhgd,bnkhd->bnhgqk', qb, kb,
                        preferred_element_type=jnp.float32) * (ATTN_HEAD_DIM ** -0.5)
    q_idx = jnp.arange(BLOCK)
    k_idx = jnp.arange(3 * BLOCK)
    rel = k_idx[None, :] - BLOCK - q_idx[:, None]
    k_abs = jnp.arange(nb)[:, None] * BLOCK - BLOCK + k_idx[None, :]
    mask = (jnp.abs(rel) <= WINDOW)[None] & ((k_abs >= 0) & (k_abs < S))[:, None, :]
    scores = jnp.where(mask[None, :, None, None], scores, NEG)
    s = sinks.astype(jnp.float32).reshape(ATTN_KV_HEADS, ATTN_GROUP)[None, None, :, :, None, None]
    m = jnp.maximum(jnp.max(scores, axis=-1, keepdims=True), s)
    p = jnp.exp(scores - m)
    probs = p / (jnp.sum(p, axis=-1, keepdims=True) + jnp.exp(s - m))
    out = jnp.einsum('bnhgqk,bnkhd->bnqhgd', probs.astype(v.dtype), vb)
    return out.reshape(B, S, Q_W)


def memory_attention(mq, mk, mv):
    B, S = mq.shape[0], mq.shape[1]
    sc = jnp.einsum('bshd,bmhd->bhsm', mq, mk,
                    preferred_element_type=jnp.float32) * (MEM_HEAD_DIM ** -0.5)
    p = jax.nn.softmax(sc, axis=-1)
    out = jnp.einsum('bhsm,bmhd->bshd', p.astype(mv.dtype), mv)
    return out.reshape(B, S, MEM_W)


def centred_depthwise_conv(x, w, b):
    S = x.shape[1]
    xp = jnp.pad(x, ((0, 0), (CONV_LEFT, CONV_WIDTH - 1 - CONV_LEFT), (0, 0)))
    y = b
    for tap in range(CONV_WIDTH):
        y = y + xp[:, tap:tap + S] * w[tap]
    return y


def block_diag_linear(x, w, b):
    B, S = x.shape[0], x.shape[1]
    xr = x.reshape(B, S, LRU_BLOCKS, LRU_BLOCK_DIM)
    return jnp.einsum('bsnd,nde->bsne', xr, w).reshape(B, S, LRU_WIDTH) + b


def _linear_combine(c1, c2):
    a1, b1 = c1
    a2, b2 = c2
    return a1 * a2, a2 * b1 + b2


def rg_lru(x, wa, ba, wx, bx, lam, reverse):
    xf = x.astype(jnp.float32)
    r = jax.nn.sigmoid(block_diag_linear(x, wa, ba).astype(jnp.float32))
    i = jax.nn.sigmoid(block_diag_linear(x, wx, bx).astype(jnp.float32))
    log_a = -LRU_C * r * jax.nn.softplus(-lam.astype(jnp.float32))
    a = jnp.exp(log_a)
    u = jnp.sqrt(-jnp.expm1(2.0 * log_a)) * (i * xf)
    _, h = lax.associative_scan(_linear_combine, (a, u), axis=1, reverse=reverse)
    return h.astype(x.dtype)


def attn_mixer(h, positions, w_in, sinks):
    B, S = h.shape[0], h.shape[1]
    p = h @ w_in
    q, k, v, mq = jnp.split(p, [Q_W, Q_W + KV_W, Q_W + 2 * KV_W], axis=-1)
    q = partial_rotary(q.reshape(B, S, ATTN_HEADS, ATTN_HEAD_DIM), positions)
    k = partial_rotary(k.reshape(B, S, ATTN_KV_HEADS, ATTN_HEAD_DIM), positions)
    v = v.reshape(B, S, ATTN_KV_HEADS, ATTN_HEAD_DIM)
    return window_gqa(q, k, v, sinks), mq.reshape(B, S, MEM_HEADS, MEM_HEAD_DIM)


def lru_mixer(h, w_in, conv_w, conv_b, wa, ba, wx, bx, lam):
    B, S = h.shape[0], h.shape[1]
    p = h @ w_in
    xb, gate, mq = jnp.split(p, [LRU_WIDTH, 2 * LRU_WIDTH], axis=-1)
    xc = centred_depthwise_conv(xb, conv_w, conv_b)
    y = (rg_lru(xc, wa[0], ba[0], wx[0], bx[0], lam[0], False)
         + rg_lru(xc, wa[1], ba[1], wx[1], bx[1], lam[1], True))
    y = y * jax.nn.gelu(gate)
    return y, mq.reshape(B, S, MEM_HEADS, MEM_HEAD_DIM)


def squared_relu_mlp(h, w_up, w_down):
    return jnp.square(jax.nn.relu(h @ w_up)) @ w_down


def setup_inputs(seed: int = 0) -> dict:
    key = jax.random.key(seed)
    ks = jax.random.split(key, 24)
    n_attn = (DEPTH + N_MIXERS - 1) // N_MIXERS
    n_lru = DEPTH // N_MIXERS
    f32 = jnp.float32

    def nrm(k, shape, scale):
        return jax.random.normal(k, shape, f32) * scale

    u = jax.random.uniform(ks[20], (n_lru, 2, LRU_WIDTH), f32, minval=0.9, maxval=0.999)
    s = u ** (1.0 / LRU_C)
    lam = jnp.log(s) - jnp.log1p(-s)
    positions = (jnp.arange(SEQ, dtype=jnp.int32)[None, :]
                 + jax.random.randint(ks[21], (BATCH, 1), 0, 1024, dtype=jnp.int32))
    return {
        "x": nrm(ks[0], (BATCH, SEQ, D_MODEL), 1.0),
        "mem": nrm(ks[1], (BATCH, MEM_LEN, D_MODEL), 1.0),
        "positions": positions,
        "mix_norm": 1.0 + nrm(ks[2], (DEPTH, D_MODEL), 0.05),
        "mlp_norm": 1.0 + nrm(ks[3], (DEPTH, D_MODEL), 0.05),
        "mem_norm": 1.0 + nrm(ks[4], (D_MODEL,), 0.05),
        "final_norm": 1.0 + nrm(ks[5], (D_MODEL,), 0.05),
        "w_mem_kv": nrm(ks[6], (DEPTH, D_MODEL, 2 * MEM_W), D_MODEL ** -0.5),
        "w_out": nrm(ks[7], (DEPTH, MIX_OUT_W, D_MODEL), MIX_OUT_W ** -0.5),
        "w_up": nrm(ks[8], (DEPTH, D_MODEL, D_FF), D_MODEL ** -0.5),
        "w_down": nrm(ks[9], (DEPTH, D_FF, D_MODEL), D_FF ** -0.5),
        "attn_w_in": nrm(ks[10], (n_attn, D_MODEL, ATTN_IN_W), D_MODEL ** -0.5),
        "attn_sinks": nrm(ks[11], (n_attn, ATTN_HEADS), 0.5),
        "lru_w_in": nrm(ks[12], (n_lru, D_MODEL, LRU_IN_W), D_MODEL ** -0.5),
        "lru_conv_w": nrm(ks[13], (n_lru, CONV_WIDTH, LRU_WIDTH), CONV_WIDTH ** -0.5),
        "lru_conv_b": nrm(ks[14], (n_lru, LRU_WIDTH), 0.02),
        "lru_wa": nrm(ks[15], (n_lru, 2, LRU_BLOCKS, LRU_BLOCK_DIM, LRU_BLOCK_DIM), LRU_BLOCK_DIM ** -0.5),
        "lru_ba": nrm(ks[16], (n_lru, 2, LRU_WIDTH), 0.02),
        "lru_wx": nrm(ks[17], (n_lru, 2, LRU_BLOCKS, LRU_BLOCK_DIM, LRU_BLOCK_DIM), LRU_BLOCK_DIM ** -0.5),
        "lru_bx": nrm(ks[18], (n_lru, 2, LRU_WIDTH), 0.02),
        "lru_lambda": lam,
    }


def reference(x, mem, positions, mix_norm, mlp_norm, mem_norm, final_norm, w_mem_kv, w_out,
              w_up, w_down, attn_w_in, attn_sinks, lru_w_in, lru_conv_w, lru_conv_b,
              lru_wa, lru_ba, lru_wx, lru_bx, lru_lambda):
    B = mem.shape[0]
    mem_n = rms_norm(mem, mem_norm)
    for l in range(DEPTH):
        kind = l % N_MIXERS
        j = l // N_MIXERS
        h = rms_norm(x, mix_norm[l])
        kv = mem_n @ w_mem_kv[l]
        mk = kv[..., :MEM_W].reshape(B, MEM_LEN, MEM_HEADS, MEM_HEAD_DIM)
        mv = kv[..., MEM_W:].reshape(B, MEM_LEN, MEM_HEADS, MEM_HEAD_DIM)
        if kind == 0:
            mixed, mq = attn_mixer(h, positions, attn_w_in[j], attn_sinks[j])
        else:
            mixed, mq = lru_mixer(h, lru_w_in[j], lru_conv_w[j], lru_conv_b[j], lru_wa[j],
                                  lru_ba[j], lru_wx[j], lru_bx[j], lru_lambda[j])
        mo = memory_attention(mq, mk, mv)
        x = x + jnp.concatenate([mixed, mo], axis=-1) @ w_out[l]
        x = x + squared_relu_mlp(rms_norm(x, mlp_norm[l]), w_up[l], w_down[l])
    return rms_norm(x, final_norm)
```

```cpp
#include <hip/hip_runtime.h>
#include <hip/hip_cooperative_groups.h>
#include <cstdio>
#include <cstdint>
namespace cg = cooperative_groups;
namespace pg8 {
#define PG8_LAS __attribute__((address_space(3)))
typedef unsigned short bf16_t;
typedef short bf16x8 __attribute__((ext_vector_type(8)));
typedef float f32x4 __attribute__((ext_vector_type(4)));
typedef unsigned u32x4 __attribute__((ext_vector_type(4)));
constexpr int BM = 256, BK = 64, HALF = 128, HTB = HALF * BK * 2  , STAGE_BYTES = 8 * HTB, NXCD = 8, WGM = 8;

__host__ __device__ __forceinline__ int lds_byte(int r, int c) { const int st = (r >> 4) * 2 + (c >> 5), rr = r & 15, cc = c & 31, ob = rr * 64 + cc * 2; return st * 1024 + (ob ^ (((ob >> 9) & 1) << 5)); }
__host__ __device__ __forceinline__ void stage_rc(int b, int& R, int& C) { const int st = b / 1024, sb = b % 1024, swz = sb ^ (((sb >> 9) & 1) << 5); R = (st >> 1) * 16 + swz / 64; C = (st & 1) * 32 + (swz % 64) / 2; }
__host__ __device__ __forceinline__ int perm32(int rho) { const int n = rho >> 4, i = rho & 15; return 8 * (i >> 2) + 4 * n + (i & 3); }

struct Unit { int pm, pn; };
struct Gemm { const bf16_t* A; const bf16_t* Bt; int M, N, K; };

struct StaticOrder {
    int nM, nN, nwg, G, c;
    __host__ __device__ void init(int M, int N, int G_, int c_) { nM = M / BM; nN = N / BM; nwg = nM * nN; G = G_; c = c_; }
    __host__ __device__ bool next(int i, Unit& u) const {
        const long L = (long)i * G + c; if (L >= nwg) return false;
        int wgid = (int)L; { const int q = nwg / NXCD, r = nwg % NXCD, xcd = wgid % NXCD, off = wgid / NXCD; wgid = (xcd < r ? xcd * (q + 1) : r * (q + 1) + (xcd - r) * q) + off; }
        const int nig = WGM * nN, gid = wgid / nig, fm = gid * WGM, gsz = (nM - fm) < WGM ? (nM - fm) : WGM;
        u.pm = fm + ((wgid % nig) % gsz); u.pn = (wgid % nig) / gsz; return true;
    }
    __device__ __forceinline__ void a_ready(const Unit&) const {}
    __device__ __forceinline__ void done(const Unit&) const {}
};

__device__ __forceinline__ unsigned cvt_pk_bf16(float lo, float hi) { unsigned r; asm volatile("v_cvt_pk_bf16_f32 %0, %1, %2" : "=v"(r) : "v"(lo), "v"(hi)); return r; }
template <class Epi, class Sched, bool ALIGN_EPI = false, bool SP2 = false>
__device__ __forceinline__ void gemm_phase(PG8_LAS unsigned char* lds, const Gemm g, const Sched& S, const Epi& E, const int wave_s) {
    int lane_; asm volatile("v_mbcnt_lo_u32_b32 %0, -1, 0\n\tv_mbcnt_hi_u32_b32 %0, -1, %0" : "=v"(lane_));
    const int tid = wave_s * 64 + lane_, wid = __builtin_amdgcn_readfirstlane(tid >> 6), lane = tid & 63, wr = wid >> 2, wc = wid & 3, fr = lane & 15, fq = lane >> 4;
    const int K = g.K, nt = K / BK;
    unsigned voffA[2], voffB[2];
#pragma unroll
    for (int i = 0; i < 2; ++i) { int R, C; stage_rc(tid * 16 + i * 8192, R, C); const int Rb = Epi::PERM ? ((R & ~31) + perm32(R & 31)) : R;
        voffA[i] = (unsigned)(R * K + C) * 2u; voffB[i] = (unsigned)(Rb * K + C) * 2u; }
    const size_t kstep = (size_t)(BK * 2);
    const size_t hstep = (size_t)HALF * K * 2;
    const size_t tstep = 2 * hstep;
    const unsigned ldsw = (unsigned)wid * 1024u;
    const int aoff = lds_byte(wr * 64 + fr, fq * 8), boff = lds_byte(wc * 32 + fr, fq * 8);
#define PG8_SA(b, h) (((b) * 2 + (h)) * HTB)
#define PG8_SB(b, h) ((4 + (b) * 2 + (h)) * HTB)
#define PG8_STAGE(bufoff, gbase, voff) do { _Pragma("unroll") for (int _i = 0; _i < 2; ++_i) \
        __builtin_amdgcn_global_load_lds((const unsigned*)((const char*)(gbase) + (voff)[_i]), (PG8_LAS unsigned*)(lds + (bufoff) + ldsw + _i * 8192), 16, 0, 0); } while (0)
#define PG8_LDA(dst, b, h) do { _Pragma("unroll") for (int m = 0; m < 4; ++m) _Pragma("unroll") for (int k = 0; k < 2; ++k) dst[m][k] = *(const PG8_LAS bf16x8*)(lds + PG8_SA(b, h) + aoff + m * 2048 + k * 1024); } while (0)
#define PG8_LDB(dst, b, h) do { _Pragma("unroll") for (int n = 0; n < 2; ++n) _Pragma("unroll") for (int k = 0; k < 2; ++k) dst[n][k] = *(const PG8_LAS bf16x8*)(lds + PG8_SB(b, h) + boff + n * 2048 + k * 1024); } while (0)
#define PG8_MMA(ai, bj, At, Bt) do { __builtin_amdgcn_s_setprio(1); _Pragma("unroll") for (int m = 0; m < 4; ++m) _Pragma("unroll") for (int n = 0; n < 2; ++n) _Pragma("unroll") for (int k = 0; k < 2; ++k) \
        acc[ai][bj][m][n] = __builtin_amdgcn_mfma_f32_16x16x32_bf16(Bt[n][k], At[m][k], acc[ai][bj][m][n], 0, 0, 0); __builtin_amdgcn_s_setprio(0); } while (0)
#define PG8_WAIT_V(n) asm volatile("s_waitcnt vmcnt(" #n ")" ::: "memory")
#define PG8_WAIT_L(n) asm volatile("s_waitcnt lgkmcnt(" #n ")" ::: "memory")
#define PG8_BAR __builtin_amdgcn_s_barrier()
#define PG8_SCHED __builtin_amdgcn_sched_barrier(0)
    Unit cur, nxt; int ui = 0;
    if (!S.next(0, cur)) return;
    f32x4 acc[2][2][4][2];
#pragma unroll
    for (int a = 0; a < 2; ++a)
#pragma unroll
        for (int b = 0; b < 2; ++b)
#pragma unroll
            for (int m = 0; m < 4; ++m)
#pragma unroll
                for (int n = 0; n < 2; ++n) acc[a][b][m][n] = (f32x4){0.f, 0.f, 0.f, 0.f};
    bf16x8 At[4][2], B0[2][2], B1[2][2];
    const char* cA = (const char*)g.A + (size_t)cur.pm * tstep; const char* cB = (const char*)g.Bt + (size_t)cur.pn * tstep;
    S.a_ready(cur);
    if constexpr (SP2) {
        PG8_STAGE(PG8_SB(0, 0), cB, voffB); PG8_STAGE(PG8_SB(0, 1), cB + hstep, voffB); PG8_STAGE(PG8_SA(0, 0), cA, voffA); PG8_STAGE(PG8_SA(0, 1), cA + hstep, voffA);
        if (wr == 1) PG8_BAR;
        PG8_WAIT_V(2); PG8_BAR;
        PG8_STAGE(PG8_SB(1, 0), cB + kstep, voffB); PG8_STAGE(PG8_SA(1, 0), cA + kstep, voffA); PG8_STAGE(PG8_SB(1, 1), cB + hstep + kstep, voffB);
        PG8_WAIT_V(6); PG8_BAR;
    } else {
        PG8_STAGE(PG8_SB(0, 0), cB, voffB); PG8_STAGE(PG8_SA(0, 0), cA, voffA); PG8_STAGE(PG8_SB(0, 1), cB + hstep, voffB); PG8_STAGE(PG8_SA(0, 1), cA + hstep, voffA);
        if (wr == 1) PG8_BAR;
        PG8_WAIT_V(4); PG8_BAR;
        PG8_STAGE(PG8_SB(1, 0), cB + kstep, voffB); PG8_STAGE(PG8_SA(1, 0), cA + kstep, voffA); PG8_STAGE(PG8_SB(1, 1), cB + hstep + kstep, voffB);
        PG8_WAIT_V(6); PG8_BAR;
    }
    for (;;) {
        const bool has_next = S.next(ui + 1, nxt);
        const char* nA = has_next ? (const char*)g.A + (size_t)nxt.pm * tstep : cA; const char* nB = has_next ? (const char*)g.Bt + (size_t)nxt.pn * tstep : cB;
        for (int t = 0; t < nt; t += 2) {
            const bool last = (t == nt - 2);
            const char* a1 = cA + (size_t)(t + 1) * kstep;
            const char* a2 = last ? nA : cA + (size_t)(t + 2) * kstep; const char* b2 = last ? nB : cB + (size_t)(t + 2) * kstep;
            const char* a3 = a2 + kstep; const char* b3 = b2 + kstep;
            if (last && has_next) S.a_ready(nxt);
            if constexpr (SP2) {
            PG8_LDB(B0, 0, 0); PG8_LDB(B1, 0, 1); PG8_SCHED; PG8_LDA(At, 0, 0); PG8_STAGE(PG8_SA(1, 1), a1 + hstep, voffA);
            PG8_WAIT_V(8); PG8_WAIT_L(0); PG8_BAR; PG8_MMA(0, 0, At, B0); PG8_MMA(0, 1, At, B1); PG8_BAR; PG8_SCHED;
            PG8_LDA(At, 0, 1); PG8_STAGE(PG8_SB(0, 0), b2, voffB); PG8_STAGE(PG8_SB(0, 1), b2 + hstep, voffB); PG8_STAGE(PG8_SA(0, 0), a2, voffA);
            PG8_WAIT_V(8); PG8_WAIT_L(0); PG8_BAR; PG8_MMA(1, 0, At, B0); PG8_MMA(1, 1, At, B1); PG8_BAR; PG8_SCHED;
            PG8_LDB(B0, 1, 0); PG8_LDB(B1, 1, 1); PG8_SCHED; PG8_LDA(At, 1, 0); PG8_STAGE(PG8_SA(0, 1), a2 + hstep, voffA);
            PG8_WAIT_V(8); PG8_WAIT_L(0); PG8_BAR; PG8_MMA(0, 0, At, B0); PG8_MMA(0, 1, At, B1); PG8_BAR; PG8_SCHED;
            PG8_LDA(At, 1, 1); PG8_STAGE(PG8_SB(1, 0), b3, voffB); PG8_STAGE(PG8_SB(1, 1), b3 + hstep, voffB); PG8_STAGE(PG8_SA(1, 0), a3, voffA);
            PG8_WAIT_V(8); PG8_WAIT_L(0); PG8_BAR; PG8_MMA(1, 0, At, B0); PG8_MMA(1, 1, At, B1); PG8_BAR; PG8_SCHED;
            } else {
            PG8_LDB(B0, 0, 0); PG8_SCHED; PG8_LDA(At, 0, 0); PG8_STAGE(PG8_SA(1, 1), a1 + hstep, voffA);
            PG8_WAIT_L(8); PG8_BAR; PG8_WAIT_L(0); PG8_MMA(0, 0, At, B0); PG8_BAR; PG8_SCHED;
            PG8_LDB(B1, 0, 1); PG8_STAGE(PG8_SB(0, 0), b2, voffB);
            PG8_BAR; PG8_WAIT_L(0); PG8_MMA(0, 1, At, B1); PG8_BAR;
            PG8_LDA(At, 0, 1); PG8_STAGE(PG8_SA(0, 0), a2, voffA);
            PG8_BAR; PG8_WAIT_L(0); PG8_MMA(1, 0, At, B0); PG8_BAR; PG8_SCHED;
            PG8_STAGE(PG8_SB(0, 1), b2 + hstep, voffB);
            PG8_WAIT_V(6); PG8_BAR; PG8_MMA(1, 1, At, B1); PG8_BAR;
            PG8_LDB(B0, 1, 0); PG8_SCHED; PG8_LDA(At, 1, 0); PG8_STAGE(PG8_SA(0, 1), a2 + hstep, voffA);
            PG8_WAIT_L(8); PG8_BAR; PG8_WAIT_L(0); PG8_MMA(0, 0, At, B0); PG8_BAR; PG8_SCHED;
            PG8_LDB(B1, 1, 1); PG8_STAGE(PG8_SB(1, 0), b3, voffB);
            PG8_BAR; PG8_WAIT_L(0); PG8_MMA(0, 1, At, B1); PG8_BAR;
            PG8_LDA(At, 1, 1); PG8_STAGE(PG8_SA(1, 0), a3, voffA);
            PG8_BAR; PG8_WAIT_L(0); PG8_MMA(1, 0, At, B0); PG8_BAR; PG8_SCHED;
            PG8_STAGE(PG8_SB(1, 1), b3 + hstep, voffB);
            PG8_WAIT_V(6); PG8_BAR; PG8_MMA(1, 1, At, B1); PG8_BAR;
            }
        }
        if constexpr (ALIGN_EPI) { if (wr == 0) PG8_BAR; }
        if constexpr (!Epi::AFTER_DRAIN) { E(acc, cur, wr, wc, fr, fq); S.done(cur); }
        if (!has_next) break;
#pragma unroll
        for (int a = 0; a < 2; ++a)
#pragma unroll
            for (int b = 0; b < 2; ++b)
#pragma unroll
                for (int m = 0; m < 4; ++m)
#pragma unroll
                    for (int n = 0; n < 2; ++n) acc[a][b][m][n] = (f32x4){0.f, 0.f, 0.f, 0.f};
        cur = nxt; cA = nA; cB = nB; ++ui;
        if constexpr (ALIGN_EPI) { if (wr == 1) PG8_BAR; }
    }
    PG8_WAIT_V(0);
    if constexpr (!ALIGN_EPI) { if (wr == 0) PG8_BAR; }
    PG8_BAR;
    if constexpr (Epi::AFTER_DRAIN) { E.fused(acc, cur, wr, wc, fr, fq, lds, wid, lane); S.done(cur); }
#undef PG8_SA
#undef PG8_SB
#undef PG8_STAGE
#undef PG8_LDA
#undef PG8_LDB
#undef PG8_MMA
#undef PG8_WAIT_V
#undef PG8_WAIT_L
#undef PG8_BAR
#undef PG8_SCHED
}
}

constexpr int NB = 4, SEQ = 8192, T = NB * SEQ, DM = 1024, DFF = 4096;
constexpr int AIN = 2048, LIN = 2560, MIXW = 1536;
constexpr float EPS = 1e-6f;
constexpr float LOG2E = 1.4426950408889634f;
constexpr int NTHREADS = 512;
constexpr int LDS_BYTES = 147456;

constexpr size_t MiB = 1u << 20;
constexpr size_t WS_SS = 0;
constexpr size_t WS_BAR = 768 * 1024;
constexpr size_t WS_ROPE = 1 * MiB;
constexpr size_t WS_SUM = 3 * MiB;
constexpr size_t WS_KM = 7 * MiB;
constexpr size_t WS_VMT = 9 * MiB;
constexpr size_t WS_MEMN = 11 * MiB;
constexpr size_t WS_W_AIN = 16 * MiB, WS_W_LIN = 20 * MiB, WS_W_OUT0 = 25 * MiB, WS_W_OUT1 = 28 * MiB, WS_W_UP0 = 31 * MiB, WS_W_UP1 = 39 * MiB,
                 WS_W_DN0 = 47 * MiB, WS_W_DN1 = 55 * MiB, WS_W_MKV = 63 * MiB, WS_W_GATE = 67 * MiB;
constexpr size_t WS_VT = 68 * MiB;
constexpr size_t WS_XB = 84 * MiB;
constexpr size_t WS_CAB = 148 * MiB;
constexpr size_t WS_P = 212 * MiB;
constexpr size_t WS_MIX = 372 * MiB;
constexpr size_t WS_H = 212 * MiB;
constexpr size_t WS_END = 468 * MiB;

using pg8::bf16_t; using pg8::bf16x8; using pg8::f32x4; using pg8::u32x4; using pg8::cvt_pk_bf16;
#define LAS __attribute__((address_space(3)))
typedef float f32x16 __attribute__((ext_vector_type(16)));
typedef short s16x4 __attribute__((ext_vector_type(4)));
typedef unsigned u32x2 __attribute__((ext_vector_type(2)));

__device__ __forceinline__ float bf2f(unsigned short h) { return __uint_as_float((unsigned)h << 16); }
__device__ __forceinline__ unsigned short f2bf(float f) { unsigned u = __float_as_uint(f); return (unsigned short)((u + 0x7fffu + ((u >> 16) & 1u)) >> 16); }
__device__ __forceinline__ u32x4 pack8(f32x4 a, f32x4 b) { u32x4 w; w.x = cvt_pk_bf16(a[0], a[1]); w.y = cvt_pk_bf16(a[2], a[3]); w.z = cvt_pk_bf16(b[0], b[1]); w.w = cvt_pk_bf16(b[2], b[3]); return w; }
__device__ __forceinline__ int crow(int r, int hi) { return (r & 3) + 8 * (r >> 2) + 4 * hi; }
__device__ __forceinline__ float fast_exp2(float x) { return __builtin_amdgcn_exp2f(x); }
__device__ __forceinline__ float fast_rcp(float x) { return __builtin_amdgcn_rcpf(x); }
__device__ __forceinline__ float sigmoidf_(float z) { return fast_rcp(1.f + fast_exp2(-z * LOG2E)); }
__device__ __forceinline__ float gelu_tanh(float x) { const float y = 0.7978845608028654f * (x + 0.044715f * x * x * x); const float t = fast_exp2(2.f * LOG2E * y); return x * (1.f - fast_rcp(t + 1.f)); }
__device__ __forceinline__ int opaque_lane() { int l; asm volatile("v_mbcnt_lo_u32_b32 %0, -1, 0\n\tv_mbcnt_hi_u32_b32 %0, -1, %0" : "=v"(l)); return l; }
__device__ __forceinline__ float wave_sum(float v) {
#pragma unroll
    for (int o = 1; o < 64; o <<= 1) v += __shfl_xor(v, o);
    return v;
}

struct EpiInL0 {
    static constexpr bool PERM = true, AFTER_DRAIN = false;
    bf16_t* P; bf16_t* VT; const float* rope;
    __device__ __forceinline__ void operator()(const f32x4 (&acc)[2][2][4][2], const pg8::Unit& u, int wr, int wc, int fr, int fq) const {
        asm volatile("" : "+v"(fr), "+v"(fq));
        const int pn = u.pn;
        const bool rot = (pn < 5) && ((wc & 1) == 0);
#pragma unroll
        for (int ai = 0; ai < 2; ++ai) {
            f32x4 rp_[4][4];
            if (rot && fq < 2) {
#pragma unroll
                for (int m = 0; m < 4; ++m) { const float* rp = rope + (size_t)(u.pm * 256 + ai * 128 + wr * 64 + m * 16 + fr) * 16;
#pragma unroll
                    for (int j = 0; j < 4; ++j) rp_[m][j] = *(const f32x4*)(rp + 4 * j); }
            }
            asm volatile("" ::: "memory");
#pragma unroll
            for (int m = 0; m < 4; ++m) {
                const int row = u.pm * 256 + ai * 128 + wr * 64 + m * 16 + fr;
#pragma unroll
                for (int bj = 0; bj < 2; ++bj) {
                    const int c0 = pn * 256 + bj * 128 + wc * 32 + 8 * fq;
                    f32x4 v0 = acc[ai][bj][m][0], v1 = acc[ai][bj][m][1];
                    if (pn == 5) {
                        const int cc = c0 - 1280, kvh = cc >> 6, d = cc & 63, b = row >> 13, s = row & (SEQ - 1);
                        bf16_t* dst = VT + ((size_t)((b * 4 + kvh) * 64 + d)) * SEQ + s;
#pragma unroll
                        for (int j = 0; j < 4; ++j) { dst[(size_t)j * SEQ] = f2bf(v0[j]); dst[(size_t)(j + 4) * SEQ] = f2bf(v1[j]); }
                    } else {
                        if (rot) {
                            f32x4 p0, p1;
#pragma unroll
                            for (int j = 0; j < 4; ++j) { p0[j] = __shfl_xor(v0[j], 16); p1[j] = __shfl_xor(v1[j], 16); }
                            if (fq < 2) {
                                const f32x4 c0v = rp_[m][0], c1v = rp_[m][1], s0v = rp_[m][2], s1v = rp_[m][3];
                                const float sg = (fq == 0) ? -1.f : 1.f;
                                v0 = v0 * c0v + (p0 * s0v) * sg; v1 = v1 * c1v + (p1 * s1v) * sg;
                            }
                        }
                        *(u32x4*)(P + (size_t)row * AIN + c0) = pack8(v0, v1);
                    }
                }
                asm volatile("" ::: "memory");
            }
        }
    }
};
struct EpiMemKV {
    static constexpr bool PERM = true, AFTER_DRAIN = false;
    bf16_t* KM; bf16_t* VMT;
    __device__ __forceinline__ void operator()(const f32x4 (&acc)[2][2][4][2], const pg8::Unit& u, int wr, int wc, int fr, int fq) const {
        asm volatile("" : "+v"(fr), "+v"(fq));
#pragma unroll
        for (int ai = 0; ai < 2; ++ai)
#pragma unroll
            for (int m = 0; m < 4; ++m) {
                const int row = u.pm * 256 + ai * 128 + wr * 64 + m * 16 + fr;
#pragma unroll
                for (int bj = 0; bj < 2; ++bj) {
                    const int c = u.pn * 256 + bj * 128 + wc * 32 + 8 * fq, l = c >> 10, j0 = c & 1023;
                    const f32x4 v0 = acc[ai][bj][m][0], v1 = acc[ai][bj][m][1];
                    if (j0 < 512) { *(u32x4*)(KM + (size_t)row * 1024 + l * 512 + j0) = pack8(v0, v1); }
                    else {
                        const int jj = j0 - 512, hm = jj >> 7, d = jj & 127, b = row >> 8, mm = row & 255;
                        bf16_t* dst = VMT + ((size_t)(((l * 4 + b) * 4 + hm) * 128 + d)) * 256 + mm;
#pragma unroll
                        for (int j = 0; j < 4; ++j) { dst[(size_t)j * 256] = f2bf(v0[j]); dst[(size_t)(j + 4) * 256] = f2bf(v1[j]); }
                    }
                }
                asm volatile("" ::: "memory");
            }
    }
};
__device__ __forceinline__ void unpack8(const u32x4 w, f32x4& a, f32x4& b2) {
    a[0] = __uint_as_float(w.x << 16); a[1] = __uint_as_float(w.x & 0xffff0000u); a[2] = __uint_as_float(w.y << 16); a[3] = __uint_as_float(w.y & 0xffff0000u);
    b2[0] = __uint_as_float(w.z << 16); b2[1] = __uint_as_float(w.z & 0xffff0000u); b2[2] = __uint_as_float(w.w << 16); b2[3] = __uint_as_float(w.w & 0xffff0000u);
}
template <bool RES_BF16>
struct EpiRes {
    static constexpr bool PERM = true, AFTER_DRAIN = false;
    const void* res; bf16_t* outb; float* ss; LAS float* part;
    __device__ __forceinline__ void operator()(const f32x4 (&acc)[2][2][4][2], const pg8::Unit& u, int wr, int wc, int fr, int fq) const {
        asm volatile("" : "+v"(fr), "+v"(fq));
#pragma unroll
        for (int ai = 0; ai < 2; ++ai) {
            f32x4 pre[4][2][2]; u32x4 prb[4][2];
#pragma unroll
            for (int m = 0; m < 4; ++m)
#pragma unroll
                for (int bj = 0; bj < 2; ++bj) {
                    const size_t off = (size_t)(u.pm * 256 + ai * 128 + wr * 64 + m * 16 + fr) * DM + u.pn * 256 + bj * 128 + wc * 32 + 8 * fq;
                    if (RES_BF16) prb[m][bj] = __builtin_nontemporal_load((const u32x4*)((const bf16_t*)res + off));
                    else { pre[m][bj][0] = __builtin_nontemporal_load((const f32x4*)((const float*)res + off)); pre[m][bj][1] = __builtin_nontemporal_load((const f32x4*)((const float*)res + off + 4)); }
                }
            asm volatile("" ::: "memory");
#pragma unroll
            for (int m = 0; m < 4; ++m) {
                const int row = u.pm * 256 + ai * 128 + wr * 64 + m * 16 + fr;
                float sq = 0.f;
#pragma unroll
                for (int bj = 0; bj < 2; ++bj) {
                    const size_t off = (size_t)row * DM + u.pn * 256 + bj * 128 + wc * 32 + 8 * fq;
                    f32x4 r0, r1;
                    if (RES_BF16) unpack8(prb[m][bj], r0, r1); else { r0 = pre[m][bj][0]; r1 = pre[m][bj][1]; }
                    const f32x4 o0 = acc[ai][bj][m][0] + r0, o1 = acc[ai][bj][m][1] + r1;
                    sq += (o0[0] * o0[0] + o0[1] * o0[1]) + (o0[2] * o0[2] + o0[3] * o0[3]) + (o1[0] * o1[0] + o1[1] * o1[1]) + (o1[2] * o1[2] + o1[3] * o1[3]);
                    *(u32x4*)(outb + off) = pack8(o0, o1);
                }
                sq += __shfl_xor(sq, 16); sq += __shfl_xor(sq, 32);
                if (fq == 0) part[(ai * 128 + wr * 64 + m * 16 + fr) * 4 + wc] = sq;
            }
            asm volatile("" ::: "memory");
        }
        asm volatile("s_waitcnt lgkmcnt(0)" ::: "memory"); __builtin_amdgcn_s_barrier(); asm volatile("" ::: "memory");
        { const int lane_ = fr + 16 * fq, row = (wr * 4 + wc) * 32 + (lane_ & 31);
          if (lane_ < 32) { const f32x4 p4 = *(const LAS f32x4*)(part + row * 4); atomicAdd(ss + u.pm * 256 + row, (p4[0] + p4[1]) + (p4[2] + p4[3])); } }
    }
};
struct EpiUp {
    static constexpr bool PERM = true, AFTER_DRAIN = false;
    bf16_t* H; const float* ss;
    __device__ __forceinline__ void operator()(const f32x4 (&acc)[2][2][4][2], const pg8::Unit& u, int wr, int wc, int fr, int fq) const {
        asm volatile("" : "+v"(fr), "+v"(fq));
        float rsv[2][4];
#pragma unroll
        for (int ai = 0; ai < 2; ++ai)
#pragma unroll
            for (int m = 0; m < 4; ++m) rsv[ai][m] = ss[u.pm * 256 + ai * 128 + wr * 64 + m * 16 + fr];
#pragma unroll
        for (int ai = 0; ai < 2; ++ai)
#pragma unroll
            for (int m = 0; m < 4; ++m) rsv[ai][m] = rsqrtf(rsv[ai][m] * (1.f / DM) + EPS);
#pragma unroll
        for (int ai = 0; ai < 2; ++ai)
#pragma unroll
            for (int m = 0; m < 4; ++m) {
                const int row = u.pm * 256 + ai * 128 + wr * 64 + m * 16 + fr;
                const float rs = rsv[ai][m];
#pragma unroll
                for (int bj = 0; bj < 2; ++bj) {
                    f32x4 v0 = acc[ai][bj][m][0] * rs, v1 = acc[ai][bj][m][1] * rs;
#pragma unroll
                    for (int j = 0; j < 4; ++j) { const float a = fmaxf(v0[j], 0.f), b = fmaxf(v1[j], 0.f); v0[j] = a * a; v1[j] = b * b; }
                    *(u32x4*)(H + (size_t)row * DFF + u.pn * 256 + bj * 128 + wc * 32 + 8 * fq) = pack8(v0, v1);
                }
                asm volatile("" ::: "memory");
            }
    }
};
struct EpiInL1 {
    static constexpr bool PERM = true, AFTER_DRAIN = false;
    bf16_t* PL; const float* ss;
    __device__ __forceinline__ void operator()(const f32x4 (&acc)[2][2][4][2], const pg8::Unit& u, int wr, int wc, int fr, int fq) const {
        asm volatile("" : "+v"(fr), "+v"(fq));
        float rsv[2][4];
#pragma unroll
        for (int ai = 0; ai < 2; ++ai)
#pragma unroll
            for (int m = 0; m < 4; ++m) rsv[ai][m] = ss[u.pm * 256 + ai * 128 + wr * 64 + m * 16 + fr];
#pragma unroll
        for (int ai = 0; ai < 2; ++ai)
#pragma unroll
            for (int m = 0; m < 4; ++m) rsv[ai][m] = rsqrtf(rsv[ai][m] * (1.f / DM) + EPS);
        const bool gate = (u.pn >= 4 && u.pn < 8);
#pragma unroll
        for (int ai = 0; ai < 2; ++ai)
#pragma unroll
            for (int m = 0; m < 4; ++m) {
                const int row = u.pm * 256 + ai * 128 + wr * 64 + m * 16 + fr;
                const float rs = rsv[ai][m];
#pragma unroll
                for (int bj = 0; bj < 2; ++bj) {
                    f32x4 v0 = acc[ai][bj][m][0] * rs, v1 = acc[ai][bj][m][1] * rs;
                    if (gate) {
#pragma unroll
                        for (int j = 0; j < 4; ++j) { v0[j] = gelu_tanh(v0[j]); v1[j] = gelu_tanh(v1[j]); }
                    }
                    *(u32x4*)(PL + (size_t)row * LIN + u.pn * 256 + bj * 128 + wc * 32 + 8 * fq) = pack8(v0, v1);
                }
                asm volatile("" ::: "memory");
            }
    }
};

struct RevRounds {
    pg8::StaticOrder so; int rounds;
    __device__ __forceinline__ void init(int M, int N, int G, int c) { so.init(M, N, G, c); rounds = (so.nwg + G - 1) / G; }
    __device__ __forceinline__ bool next(int i, pg8::Unit& u) const { return i < rounds && so.next(rounds - 1 - i, u); }
    __device__ __forceinline__ void a_ready(const pg8::Unit&) const {}
    __device__ __forceinline__ void done(const pg8::Unit&) const {}
};

constexpr int TP_STR = 65, TP_BYTES = 64 * TP_STR * 4;
__device__ __forceinline__ void transpose_tile64(const float* W, int ldw, int k0, int n0, bf16_t* dst, int ldd, const float* gk, int gate_g, LAS float* scr, int lane) {
    const int l16 = lane & 15, lr = lane >> 4;
    f32x4 v[16];
#pragma unroll
    for (int i = 0; i < 16; ++i) v[i] = __builtin_nontemporal_load((const f32x4*)(W + (size_t)(k0 + 4 * i + lr) * ldw + n0 + 4 * l16));
    if (gk) {
#pragma unroll
        for (int i = 0; i < 16; ++i) v[i] = v[i] * gk[k0 + 4 * i + lr];
    }
#pragma unroll
    for (int i = 0; i < 16; ++i) { LAS float* p = scr + (4 * i + lr) * TP_STR + 4 * l16; p[0] = v[i][0]; p[1] = v[i][1]; p[2] = v[i][2]; p[3] = v[i][3]; }
    asm volatile("s_waitcnt lgkmcnt(0)" ::: "memory");
    const int c = lane & 7;
#pragma unroll
    for (int j = 0; j < 8; ++j) { const int n = (lane >> 3) + 8 * j; const LAS float* s = scr + (8 * c) * TP_STR + n;
        u32x4 o; o.x = cvt_pk_bf16(s[0 * TP_STR], s[1 * TP_STR]); o.y = cvt_pk_bf16(s[2 * TP_STR], s[3 * TP_STR]); o.z = cvt_pk_bf16(s[4 * TP_STR], s[5 * TP_STR]); o.w = cvt_pk_bf16(s[6 * TP_STR], s[7 * TP_STR]);
        const int ng = n0 + n, row = (gate_g >= 0) ? ((ng >> 5) * 128 + gate_g * 32 + (ng & 31)) : ng;
        *(u32x4*)(dst + (size_t)row * ldd + k0 + 8 * c) = o; }
    asm volatile("s_waitcnt lgkmcnt(0)" ::: "memory");
}
__device__ __forceinline__ void transpose_matrix(const float* W, int K, int N, bf16_t* WT, const float* gk, LAS float* scr, int lane, int gw, int ngw) {
    const int nblk = N / 64, nitems = (K / 64) * nblk;
    for (int it = gw; it < nitems; it += ngw) { const int kb = it / nblk, nb = it % nblk; transpose_tile64(W, N, 64 * kb, 64 * nb, WT, K, gk, -1, scr, lane); }
}
__device__ __forceinline__ void rms_row_to_bf16(const float* xrow, const float* g, bf16_t* orow, int lane) {
    const f32x4* xr = (const f32x4*)xrow + lane; const f32x4* gr = (const f32x4*)g + lane;
    f32x4 v[4]; float s = 0.f;
#pragma unroll
    for (int j = 0; j < 4; ++j) { v[j] = xr[64 * j]; s += (v[j].x * v[j].x + v[j].y * v[j].y) + (v[j].z * v[j].z + v[j].w * v[j].w); }
    const float rs = rsqrtf(wave_sum(s) * (1.f / DM) + EPS);
    u32x2* o8 = (u32x2*)orow + lane;
#pragma unroll
    for (int j = 0; j < 4; ++j) { const f32x4 gg = gr[64 * j]; u32x2 w; w.x = cvt_pk_bf16(v[j].x * rs * gg.x, v[j].y * rs * gg.y); w.y = cvt_pk_bf16(v[j].z * rs * gg.z, v[j].w * rs * gg.w); o8[64 * j] = w; }
}

__device__ __forceinline__ void rms_rows4_to_bf16(const float* xrow, const float* g, bf16_t* orow, int lane) {
    f32x4 v[4][4]; float s[4];
#pragma unroll
    for (int i = 0; i < 4; ++i)
#pragma unroll
        for (int j = 0; j < 4; ++j) v[i][j] = __builtin_nontemporal_load((const f32x4*)(xrow + (size_t)i * DM) + lane + 64 * j);
#pragma unroll
    for (int i = 0; i < 4; ++i) { s[i] = 0.f;
#pragma unroll
        for (int j = 0; j < 4; ++j) s[i] += (v[i][j].x * v[i][j].x + v[i][j].y * v[i][j].y) + (v[i][j].z * v[i][j].z + v[i][j].w * v[i][j].w); }
#pragma unroll
    for (int o = 1; o < 64; o <<= 1) {
#pragma unroll
        for (int i = 0; i < 4; ++i) s[i] += __shfl_xor(s[i], o); }
    const f32x4* gr = (const f32x4*)g + lane;
#pragma unroll
    for (int i = 0; i < 4; ++i) { const float rs = rsqrtf(s[i] * (1.f / DM) + EPS); u32x2* o8 = (u32x2*)(orow + (size_t)i * DM) + lane;
#pragma unroll
        for (int j = 0; j < 4; ++j) { const f32x4 gg = gr[64 * j]; u32x2 w; w.x = cvt_pk_bf16(v[i][j].x * rs * gg.x, v[i][j].y * rs * gg.y); w.y = cvt_pk_bf16(v[i][j].z * rs * gg.z, v[i][j].w * rs * gg.w); o8[64 * j] = w; } }
}

__device__ __forceinline__ float half_max(float x) { auto rr = __builtin_amdgcn_permlane32_swap(__float_as_uint(x), __float_as_uint(x), false, false); return fmaxf(__uint_as_float(rr[0]), __uint_as_float(rr[1])); }
__device__ __forceinline__ float half_sum(float x) { auto rr = __builtin_amdgcn_permlane32_swap(__float_as_uint(x), __float_as_uint(x), false, false); return __uint_as_float(rr[0]) + __uint_as_float(rr[1]); }
__device__ __forceinline__ float swap32(float x, int hi) { auto rr = __builtin_amdgcn_permlane32_swap(__float_as_uint(x), __float_as_uint(x), false, false); return __uint_as_float(hi ? rr[0] : rr[1]); }
template <int D, int KSTRB, int VSTRB, bool WIN, int NQ>
__device__ __forceinline__ void attn_rows(const LAS unsigned char* Kl, const LAS unsigned char* Vl, const bf16_t* qrow, size_t qgstride, int kt_lo, int kt_hi, int q0, int qi,
                                          float sinkl2, float C1, bf16_t* orow0, int ldo, int r32, int hi) {
    constexpr int ND = D / 16, NG = D / 32, NC = (NQ == 1) ? 2 : 1;
    bf16x8 qf[NQ][ND];
#pragma unroll
    for (int n = 0; n < NQ; ++n)
#pragma unroll
        for (int d0 = 0; d0 < ND; ++d0) qf[n][d0] = __builtin_nontemporal_load((const bf16x8*)(qrow + n * qgstride + d0 * 16 + hi * 8));
    float m2[NQ], l[NQ]; f32x16 o[NQ][NG];
#pragma unroll
    for (int n = 0; n < NQ; ++n) {
        m2[n] = WIN ? sinkl2 : -1e30f; l[n] = 0.f;
#pragma unroll
        for (int g = 0; g < NG; ++g)
#pragma unroll
            for (int r = 0; r < 16; ++r) o[n][g][r] = 0.f;
    }
    for (int kt = kt_lo; kt < kt_hi; ++kt) {
        if (WIN) { if (kt < 4 && kt * 32 + 31 < q0) continue; if (kt >= 8 && (kt - 8) * 32 > q0 + 32 * NQ - 1) continue; }
        const LAS unsigned char* kp = Kl + (kt * 32 + r32) * KSTRB + hi * 16;
        const int cmsk = (kt >= 8) ? -1 : 0; int thr_t[NQ];
#pragma unroll
        for (int n = 0; n < NQ; ++n) { const int qn = qi + 32 * n - 4 * hi - kt * 32; thr_t[n] = (kt < 4) ? qn : ((kt >= 8) ? ~(qn + 256) : -1000); }
        bf16x8 kf[ND];
#pragma unroll
        for (int d0 = 0; d0 < ND; ++d0) kf[d0] = *(const LAS bf16x8*)(kp + d0 * 32);
        f32x16 st[NQ][NC];
#pragma unroll
        for (int n = 0; n < NQ; ++n)
#pragma unroll
            for (int c = 0; c < NC; ++c)
#pragma unroll
                for (int r = 0; r < 16; ++r) st[n][c][r] = (WIN && c == 0) ? (((crow(r, 0) ^ cmsk) >= thr_t[n]) ? 0.f : -1e30f) : 0.f;
#pragma unroll
        for (int d0 = 0; d0 < ND; ++d0)
#pragma unroll
            for (int n = 0; n < NQ; ++n) st[n][d0 % NC] = __builtin_amdgcn_mfma_f32_32x32x16_bf16(kf[d0], qf[n][d0], st[n][d0 % NC], 0, 0, 0);
        bf16x8 pa[NQ][2];
#pragma unroll
        for (int n = 0; n < NQ; ++n) {
            float p[16]; float tmax = -1e30f;
#pragma unroll
            for (int r = 0; r < 16; ++r) {
                float s = st[n][0][r]; if (NC == 2) s += st[n][NC - 1][r];
                p[r] = s; tmax = fmaxf(tmax, s);
            }
            tmax = half_max(tmax) * C1;
            if (__any(tmax > m2[n] + 8.f)) {
                const float mn = fmaxf(m2[n], tmax), f = fast_exp2(m2[n] - mn);
                l[n] *= f; m2[n] = mn;
#pragma unroll
                for (int r = 0; r < 16; ++r) { const float fr_ = __shfl(f, crow(r, hi));
#pragma unroll
                    for (int g = 0; g < NG; ++g) o[n][g][r] *= fr_; }
            }
#pragma unroll
            for (int r = 0; r < 16; ++r) { p[r] = fast_exp2(p[r] * C1 - m2[n]); l[n] += p[r]; }
            u32x4 w0, w1; w0.x = cvt_pk_bf16(p[0], p[1]); w0.y = cvt_pk_bf16(p[2], p[3]); w0.z = cvt_pk_bf16(p[4], p[5]); w0.w = cvt_pk_bf16(p[6], p[7]);
            w1.x = cvt_pk_bf16(p[8], p[9]); w1.y = cvt_pk_bf16(p[10], p[11]); w1.z = cvt_pk_bf16(p[12], p[13]); w1.w = cvt_pk_bf16(p[14], p[15]);
            pa[n][0] = __builtin_bit_cast(bf16x8, w0); pa[n][1] = __builtin_bit_cast(bf16x8, w1);
        }
#pragma unroll
        for (int h2 = 0; h2 < 2; ++h2) {
            bf16x8 vb[NG];
#pragma unroll
            for (int g = 0; g < NG; ++g) {
                const LAS unsigned char* vp = Vl + (g * 32 + r32) * VSTRB + (kt * 32 + 16 * h2 + 4 * hi) * 2;
                const s16x4 lo = *(const LAS s16x4*)vp, hh = *(const LAS s16x4*)(vp + 16);
                vb[g] = (bf16x8){lo[0], lo[1], lo[2], lo[3], hh[0], hh[1], hh[2], hh[3]};
            }
#pragma unroll
            for (int g = 0; g < NG; ++g)
#pragma unroll
                for (int n = 0; n < NQ; ++n) o[n][g] = __builtin_amdgcn_mfma_f32_32x32x16_bf16(pa[n][h2], vb[g], o[n][g], 0, 0, 0);
        }
    }
#pragma unroll
    for (int n = 0; n < NQ; ++n) {
        float lt = half_sum(l[n]); if (WIN) lt += fast_exp2(sinkl2 - m2[n]);
        const float linv = 1.f / lt;
#pragma unroll
        for (int r = 0; r < 16; ++r) {
            const int q = crow(r, hi); const float li = __shfl(linv, q);
#pragma unroll
            for (int g = 0; g < NG; ++g) orow0[(size_t)(32 * n + q) * ldo + g * 32 + r32] = f2bf(o[n][g][r] * li);
        }
    }
}

constexpr int WK_STR = 144, WV_STR = 784, WV_OFF = 384 * WK_STR;
__device__ __forceinline__ void wattn_unit(LAS unsigned char* lds, const bf16_t* P, const bf16_t* VT, bf16_t* MIX, const float* sinks, int b, int nblk, int kvh, const int wave_s) {
    const int lane = opaque_lane(), wid = wave_s, tid = wid * 64 + lane, r32 = lane & 31, hi = lane >> 5;
    const int s0 = nblk * 128 - 128;
    {
        u32x4 kv_[6], vv_[6];
#pragma unroll
        for (int k = 0; k < 6; ++k) { const int i = tid + NTHREADS * k, row = i >> 3, ch = i & 7; int s = s0 + row; s = s < 0 ? 0 : (s > SEQ - 1 ? SEQ - 1 : s);
            kv_[k] = __builtin_nontemporal_load((const u32x4*)(P + ((size_t)(b * SEQ + s)) * AIN + 1024 + kvh * 64 + ch * 8)); }
#pragma unroll
        for (int k = 0; k < 6; ++k) { const int i = tid + NTHREADS * k, d = i / 48, ch = i % 48; int s = s0 + ch * 8; s = s < 0 ? 0 : (s > SEQ - 8 ? SEQ - 8 : s);
            vv_[k] = __builtin_nontemporal_load((const u32x4*)(VT + ((size_t)((b * 4 + kvh) * 64 + d)) * SEQ + s)); }
#pragma unroll
        for (int k = 0; k < 6; ++k) { const int i = tid + NTHREADS * k, row = i >> 3, ch = i & 7; *(LAS u32x4*)(lds + row * WK_STR + ch * 16) = kv_[k]; }
#pragma unroll
        for (int k = 0; k < 6; ++k) { const int i = tid + NTHREADS * k, d = i / 48, ch = i % 48; *(LAS u32x4*)(lds + WV_OFF + d * WV_STR + ch * 16) = vv_[k]; }
    }
    __syncthreads();
    const int hq = kvh * 4 + (wid >> 1);
    const float sinkl2 = sinks[hq] * LOG2E;
    const int kt_lo = (nblk == 0) ? 4 : 0, kt_hi = (nblk == SEQ / 128 - 1) ? 8 : 12;
    {
        const int q0 = (wid & 1) * 64, qi = q0 + r32;
        const size_t tok0 = (size_t)b * SEQ + nblk * 128 + q0;
        attn_rows<64, WK_STR, WV_STR, true, 2>(lds, lds + WV_OFF, P + (tok0 + r32) * AIN + hq * 64, (size_t)32 * AIN, kt_lo, kt_hi, q0, qi, sinkl2, 0.125f * LOG2E,
                                              MIX + tok0 * MIXW + hq * 64, MIXW, r32, hi);
    }
    __syncthreads();
}
constexpr int MK_STR = 272, MV_STR = 528, MV_OFF = 256 * MK_STR;
__device__ __forceinline__ void mattn_unit(LAS unsigned char* lds, const bf16_t* PQ, int ldq, int qcol, const bf16_t* KM, const bf16_t* VMT, bf16_t* MIX, int layer, int b, int hm, int qblk, const int wave_s) {
    const int lane = opaque_lane(), wid = wave_s, tid = wid * 64 + lane, r32 = lane & 31, hi = lane >> 5;
    {
        u32x4 kv_[8], vv_[8];
#pragma unroll
        for (int k = 0; k < 8; ++k) { const int i = tid + NTHREADS * k, row = i >> 4, ch = i & 15; kv_[k] = *(const u32x4*)(KM + ((size_t)(b * 256 + row)) * 1024 + layer * 512 + hm * 128 + ch * 8); }
#pragma unroll
        for (int k = 0; k < 8; ++k) { const int i = tid + NTHREADS * k, d = i >> 5, ch = i & 31; vv_[k] = *(const u32x4*)(VMT + ((size_t)(((layer * 4 + b) * 4 + hm) * 128 + d)) * 256 + ch * 8); }
#pragma unroll
        for (int k = 0; k < 8; ++k) { const int i = tid + NTHREADS * k, row = i >> 4, ch = i & 15; *(LAS u32x4*)(lds + row * MK_STR + ch * 16) = kv_[k]; }
#pragma unroll
        for (int k = 0; k < 8; ++k) { const int i = tid + NTHREADS * k, d = i >> 5, ch = i & 31; *(LAS u32x4*)(lds + MV_OFF + d * MV_STR + ch * 16) = vv_[k]; }
    }
    __syncthreads();
    for (int qg = 0; qg < 2; ++qg) {
        const size_t tok0 = (size_t)b * SEQ + qblk * 512 + wid * 64 + qg * 32;
        attn_rows<128, MK_STR, MV_STR, false, 1>(lds, lds + MV_OFF, PQ + (tok0 + r32) * ldq + qcol + hm * 128, 0, 0, 8, 0, 0, 0.f, 0.08838834764831845f * LOG2E,
                                                 MIX + tok0 * MIXW + 1024 + hm * 128, MIXW, r32, hi);
    }
    __syncthreads();
}

template <int DIR>
__device__ __forceinline__ void lru_tg(f32x16& a, f32x16& u, int hi, float& Pc, float& Xc) {
#pragma unroll
    for (int q = 0; q < 4; ++q) {
        const int r0 = q * 4;
        if (DIR == 0) { float c = a[r0], h = u[r0];
#pragma unroll
            for (int i = 1; i < 4; ++i) { h = a[r0 + i] * h + u[r0 + i]; c *= a[r0 + i]; a[r0 + i] = c; u[r0 + i] = h; } }
        else { float c = a[r0 + 3], h = u[r0 + 3];
#pragma unroll
            for (int i = 2; i >= 0; --i) { h = a[r0 + i] * h + u[r0 + i]; c *= a[r0 + i]; a[r0 + i] = c; u[r0 + i] = h; } }
    }
    const bool lead = (hi == DIR);
#pragma unroll
    for (int jj = 0; jj < 4; ++jj) {
        const int q = DIR ? 3 - jj : jj, rl = DIR ? q * 4 : q * 4 + 3;
        const float C = a[rl], H = u[rl];
        const float Pe = C * Pc, Xe = C * Xc + H;
        const float Pp = swap32(Pe, hi), Xp = swap32(Xe, hi);
        const float Pin = lead ? Pc : Pp, Xin = lead ? Xc : Xp;
        const float Pf = C * Pin, Xf = C * Xin + H;
        Pc = swap32(Pf, hi); Xc = swap32(Xf, hi);
#pragma unroll
        for (int i = 0; i < 4; ++i) { const int r = q * 4 + i; u[r] += a[r] * Xin; a[r] *= Pin; }
    }
}

struct LruP { const bf16_t* PL; const float* conv_w; const float* conv_b; const float* ba; const float* bx; const float* lam; const bf16_t* WG; bf16_t* CAF; bf16_t* CAB; bf16_t* MIX; float* SUM; };
constexpr int XC_STR = 272, HS_OFF = 128 * XC_STR;
constexpr int CW_OFF = HS_OFF + 65536;
__device__ __forceinline__ void lru_conv_load(const LruP& L, int uidx, int tid, bf16x8 (&xv)[7]) {
    const int blk = uidx & 7, c = (uidx >> 3) & 63, b = uidx >> 9, cbase = blk * 128 + (tid & 15) * 8, t0 = (tid >> 4) * 4;
#pragma unroll
    for (int i = 0; i < 7; ++i) { const int s = c * 128 + t0 + i - 1, sc = s < 0 ? 0 : (s > SEQ - 1 ? SEQ - 1 : s);
        xv[i] = __builtin_nontemporal_load((const bf16x8*)(L.PL + ((size_t)(b * SEQ + sc)) * LIN + cbase)); }
}
__device__ __forceinline__ void lru_conv_finish(LAS unsigned char* lds, int uidx, int tid, const bf16x8 (&xv)[7]) {
    const int c = (uidx >> 3) & 63, ch8 = tid & 15, t0 = (tid >> 4) * 4;
    const LAS float* cw = (const LAS float*)(lds + CW_OFF);
    float xf[7][8];
#pragma unroll
    for (int i = 0; i < 7; ++i) { const int s = c * 128 + t0 + i - 1; const float mk = (s >= 0 && s < SEQ) ? 1.f : 0.f;
#pragma unroll
        for (int j = 0; j < 8; ++j) xf[i][j] = bf2f((unsigned short)xv[i][j]) * mk; }
    float sum[4][8];
    { const f32x4 b0 = *(const LAS f32x4*)(cw + 512 + ch8 * 8), b1 = *(const LAS f32x4*)(cw + 512 + ch8 * 8 + 4);
#pragma unroll
      for (int k = 0; k < 4; ++k)
#pragma unroll
          for (int j = 0; j < 4; ++j) { sum[k][j] = b0[j]; sum[k][j + 4] = b1[j]; } }
#pragma unroll
    for (int tap = 0; tap < 4; ++tap) {
        const f32x4 w0 = *(const LAS f32x4*)(cw + tap * 128 + ch8 * 8), w1 = *(const LAS f32x4*)(cw + tap * 128 + ch8 * 8 + 4);
#pragma unroll
        for (int k = 0; k < 4; ++k)
#pragma unroll
            for (int j = 0; j < 4; ++j) { sum[k][j] += xf[k + tap][j] * w0[j]; sum[k][j + 4] += xf[k + tap][j + 4] * w1[j]; }
    }
#pragma unroll
    for (int k = 0; k < 4; ++k) { u32x4 o; o.x = cvt_pk_bf16(sum[k][0], sum[k][1]); o.y = cvt_pk_bf16(sum[k][2], sum[k][3]); o.z = cvt_pk_bf16(sum[k][4], sum[k][5]); o.w = cvt_pk_bf16(sum[k][6], sum[k][7]);
        *(LAS u32x4*)(lds + (t0 + k) * XC_STR + ch8 * 16) = o; }
}
__device__ __forceinline__ void lru_units(LAS unsigned char* lds, const LruP& L, int bx, int G, const int wave_s) {
    const int lane = opaque_lane(), wid = wave_s, tid = wid * 64 + lane, r32 = lane & 31, hi = lane >> 5;
    const int cg_ = wid & 3, dir = wid >> 2;
    int cur_blk = -1; float nba = 0.f, nbx = 0.f, sp16 = 0.f, spl = 0.f; bf16x8 bfr[2][8];
#pragma unroll
    for (int gi = 0; gi < 2; ++gi)
#pragma unroll
        for (int ks = 0; ks < 8; ++ks) bfr[gi][ks] = (bf16x8){0, 0, 0, 0, 0, 0, 0, 0};
    bf16x8 xv[7];
    int uidx = bx;
    if (uidx < 2048) lru_conv_load(L, uidx, tid, xv);
    for (; uidx < 2048; uidx += G) {
        const int blk = uidx & 7, c = (uidx >> 3) & 63, b = uidx >> 9, ch = blk * 128 + cg_ * 32 + r32;
        if (blk != cur_blk) {
            cur_blk = blk;
            if (tid < 160) { const int row = tid >> 5, col = (tid & 31) * 4;
                const f32x4 v = (row < 4) ? *(const f32x4*)(L.conv_w + row * 1024 + blk * 128 + col) : *(const f32x4*)(L.conv_b + blk * 128 + col);
                *(LAS f32x4*)(lds + CW_OFF + (row * 128 + col) * 4) = v; }
            nba = -L.ba[dir * 1024 + ch] * LOG2E; nbx = -L.bx[dir * 1024 + ch] * LOG2E;
            { const float xs = fast_exp2(-L.lam[dir * 1024 + ch] * LOG2E);
              const float ser = xs * (1.f - xs * (0.5f - xs * (0.33333334f - xs * 0.25f))), big = 0.6931471805599453f * __builtin_amdgcn_logf(1.f + xs);
              const float sp8 = -8.f * ((xs < 0.03f) ? ser : big); sp16 = 2.f * sp8; spl = sp8 * LOG2E; }
            const bf16_t* wrow = L.WG + ((size_t)(blk * 512 + cg_ * 128 + dir * 64 + r32)) * 128 + hi * 8;
#pragma unroll
            for (int ks = 0; ks < 8; ++ks) { bfr[0][ks] = *(const bf16x8*)(wrow + ks * 16); bfr[1][ks] = *(const bf16x8*)(wrow + 32 * 128 + ks * 16); }
            __syncthreads();
        }
        lru_conv_finish(lds, uidx, tid, xv);
        __syncthreads();
        if (uidx + G < 2048) lru_conv_load(L, uidx + G, tid, xv);
        {
            float Pc = 1.f, Xc = 0.f;
            const size_t tokbase = (size_t)b * SEQ + c * 128;
            bf16_t* ca = (dir == 0 ? L.CAF : L.CAB) + tokbase * DM + ch;
#pragma nounroll
            for (int it = 0; it < 4; ++it) {
                const int tg = dir ? 3 - it : it;
                f32x16 a, u;
#pragma unroll
                for (int r = 0; r < 16; ++r) { a[r] = 0.f; u[r] = 0.f; }
                const LAS unsigned char* xrow = lds + (tg * 32 + r32) * XC_STR + hi * 16;
                bf16x8 af[8];
#pragma unroll
                for (int ks = 0; ks < 8; ++ks) af[ks] = *(const LAS bf16x8*)(xrow + ks * 32);
#pragma unroll
                for (int ks = 0; ks < 8; ++ks) { a = __builtin_amdgcn_mfma_f32_32x32x16_bf16(af[ks], bfr[0][ks], a, 0, 0, 0); u = __builtin_amdgcn_mfma_f32_32x32x16_bf16(af[ks], bfr[1][ks], u, 0, 0, 0); }
                const LAS unsigned char* xcol = lds + (tg * 32 + 4 * hi) * XC_STR + (cg_ * 32 + r32) * 2;
                unsigned short xq[16];
#pragma unroll
                for (int r = 0; r < 16; ++r) xq[r] = *(const LAS unsigned short*)(xcol + crow(r, 0) * XC_STR);
#pragma unroll
                for (int r = 0; r < 16; ++r) {
                    const float xcv = bf2f(xq[r]);
                    const float rr = fast_rcp(1.f + fast_exp2(a[r] * (-LOG2E) + nba)), ii = fast_rcp(1.f + fast_exp2(u[r] * (-LOG2E) + nbx));
                    const float t2 = sp16 * rr;
                    const float ser = -t2 * (1.f + t2 * (0.5f + t2 * (0.16666667f + t2 * 0.041666668f)));
                    const float av = fast_exp2(spl * rr);
                    const float m1 = (t2 > -0.0625f) ? ser : (1.f - av * av);
                    a[r] = av;
                    u[r] = __builtin_amdgcn_sqrtf(m1) * ii * xcv;
                }
                if (dir == 0) lru_tg<0>(a, u, hi, Pc, Xc); else lru_tg<1>(a, u, hi, Pc, Xc);
                bf16_t* cat = ca + (size_t)(tg * 32 + 4 * hi) * DM;
                LAS unsigned short* hst = (LAS unsigned short*)(lds + HS_OFF + dir * 32768) + (tg * 32 + 4 * hi) * 128 + cg_ * 32 + r32;
#pragma unroll
                for (int r = 0; r < 16; r += 2) {
                    const unsigned pa_ = cvt_pk_bf16(a[r], a[r + 1]), pu_ = cvt_pk_bf16(u[r], u[r + 1]);
                    cat[(size_t)crow(r, 0) * DM] = (unsigned short)pa_; cat[(size_t)crow(r + 1, 0) * DM] = (unsigned short)(pa_ >> 16);
                    hst[crow(r, 0) * 128] = (unsigned short)pu_; hst[crow(r + 1, 0) * 128] = (unsigned short)(pu_ >> 16);
                }
            }
            if (hi == dir) { float* sp = L.SUM + ((size_t)(dir * 2) * 256 + (b * 64 + c)) * 1024 + ch; sp[0] = Pc; sp[(size_t)256 * 1024] = Xc; }
        }
        __syncthreads();
        {
            const size_t tokbase = (size_t)b * SEQ + c * 128;
#pragma unroll
            for (int k = 0; k < 4; ++k) {
                const int i = tid + NTHREADS * k, t = i >> 4, c8 = i & 15;
                const bf16x8 hf = *(const LAS bf16x8*)(lds + HS_OFF + (t * 128 + c8 * 8) * 2), hb = *(const LAS bf16x8*)(lds + HS_OFF + 32768 + (t * 128 + c8 * 8) * 2);
                float y[8];
#pragma unroll
                for (int j = 0; j < 8; ++j) y[j] = bf2f((unsigned short)hf[j]) + bf2f((unsigned short)hb[j]);
                u32x4 o; o.x = cvt_pk_bf16(y[0], y[1]); o.y = cvt_pk_bf16(y[2], y[3]); o.z = cvt_pk_bf16(y[4], y[5]); o.w = cvt_pk_bf16(y[6], y[7]);
                *(u32x4*)(L.MIX + (tokbase + t) * MIXW + blk * 128 + c8 * 8) = o;
            }
        }
        __syncthreads();
    }
}
__device__ __forceinline__ void lru_fix_unit(LAS unsigned char* lds, const float* SUM, const bf16_t* CAF, const bf16_t* CAB, const bf16_t* PL, bf16_t* MIX, int b, int c, const int wave_s) {
    const int tid = wave_s * 64 + opaque_lane();
    LAS float* car = (LAS float*)lds;
    {
        const int dir = tid >> 8, ch = (tid & 255) * 4;
        const float* SA = SUM + ((size_t)(dir * 2) * 256 + b * 64) * 1024 + ch; const float* SH = SA + (size_t)256 * 1024;
        f32x4 X = (f32x4){0.f, 0.f, 0.f, 0.f};
        const int n = dir ? 63 - c : c, first = dir ? 63 : 0, step = dir ? -1 : 1;
        for (int i0 = 0; i0 < n; i0 += 16) {
            f32x4 A[16], H[16];
#pragma unroll
            for (int j = 0; j < 16; ++j) { const int i = (i0 + j < n) ? i0 + j : n - 1, cc = first + step * i; A[j] = *(const f32x4*)(SA + (size_t)cc * 1024); H[j] = *(const f32x4*)(SH + (size_t)cc * 1024); }
#pragma unroll
            for (int j = 0; j < 16; ++j) if (i0 + j < n) X = A[j] * X + H[j];
        }
        *(LAS f32x4*)(car + dir * 1024 + ch) = X;
    }
    __syncthreads();
    const int ch8 = (tid & 127) * 8;
    float cf[8], cb[8];
#pragma unroll
    for (int j = 0; j < 8; ++j) { cf[j] = car[ch8 + j]; cb[j] = car[1024 + ch8 + j]; }
    for (int k0 = 0; k0 < 32; k0 += 8) {
        bf16x8 hs[8], af[8], ab[8], gt[8];
#pragma unroll
        for (int kk = 0; kk < 8; ++kk) {
            const size_t tok = (size_t)b * SEQ + c * 128 + (tid >> 7) + 4 * (k0 + kk);
            hs[kk] = __builtin_nontemporal_load((const bf16x8*)(MIX + tok * MIXW + ch8)); af[kk] = __builtin_nontemporal_load((const bf16x8*)(CAF + tok * DM + ch8)); ab[kk] = __builtin_nontemporal_load((const bf16x8*)(CAB + tok * DM + ch8)); gt[kk] = __builtin_nontemporal_load((const bf16x8*)(PL + tok * LIN + 1024 + ch8));
        }
#pragma unroll
        for (int kk = 0; kk < 8; ++kk) {
            const size_t tok = (size_t)b * SEQ + c * 128 + (tid >> 7) + 4 * (k0 + kk);
            float y[8];
#pragma unroll
            for (int j = 0; j < 8; ++j) y[j] = (bf2f((unsigned short)hs[kk][j]) + bf2f((unsigned short)af[kk][j]) * cf[j] + bf2f((unsigned short)ab[kk][j]) * cb[j]) * bf2f((unsigned short)gt[kk][j]);
            u32x4 o; o.x = cvt_pk_bf16(y[0], y[1]); o.y = cvt_pk_bf16(y[2], y[3]); o.z = cvt_pk_bf16(y[4], y[5]); o.w = cvt_pk_bf16(y[6], y[7]);
            *(u32x4*)(MIX + tok * MIXW + ch8) = o;
        }
    }
    __syncthreads();
}

#define RLX_AGENT __ATOMIC_RELAXED, __HIP_MEMORY_SCOPE_AGENT
#define XB_TMO      128
#define XB_XCNT(j)  (256  + 64 * (j))
#define XB_XSUB(j)  (1280 + 64 * (j))
#define XB_XGEN(j)  (2304 + 64 * (j))
#define XB_TOP      3328
#define XB_TOPGEN   3392
#define XCD_BAR_WORDS 3456
#define XB_SPIN_CAP (1u << 18)

__device__ __forceinline__ unsigned xb_ld(unsigned* p)              { return __hip_atomic_load(p, __ATOMIC_RELAXED, __HIP_MEMORY_SCOPE_AGENT); }
__device__ __forceinline__ unsigned xb_add(unsigned* p, unsigned v) { return __hip_atomic_fetch_add(p, v, __ATOMIC_RELAXED, __HIP_MEMORY_SCOPE_AGENT); }
__device__ __forceinline__ unsigned xb_xcc_id() { return (unsigned)__builtin_amdgcn_s_getreg((3 << 11) | 20) & 0xFu; }
#define XB_SPIN(cond, bar) do { unsigned _sp = 0; while (cond) { __builtin_amdgcn_s_sleep(1); \
    if ((++_sp & 255u) == 0u) { if (xb_ld(&(bar)[XB_TMO])) break; if (_sp > XB_SPIN_CAP) { atomicAdd(&(bar)[XB_TMO], 1u); break; } } } } while (0)

struct XcdBarrier {
    unsigned* bar; unsigned x;
    volatile LAS unsigned* st;
};

__device__ __forceinline__ XcdBarrier xcd_barrier_post(unsigned* bar, volatile LAS unsigned* st) {
    XcdBarrier b; b.bar = bar; b.x = xb_xcc_id(); b.st = st;
    if (threadIdx.x == 0) (void)xb_add(&bar[XB_XCNT(b.x)], 1u);
    return b;
}
__device__ __forceinline__ void xcd_barrier_complete(unsigned* bar, unsigned x, unsigned& nloc, unsigned& nx) {
    const unsigned G = gridDim.x * gridDim.y * gridDim.z;
    unsigned sum, cnt, mine, sp = 0u;
    for (;;) {
        sum = 0u; cnt = 0u; mine = 0u;
#pragma unroll
        for (unsigned j = 0; j < 16; ++j) { const unsigned c = xb_ld(&bar[XB_XCNT(j)]); sum += c; cnt += (c > 0u) ? 1u : 0u; mine = (j == x) ? c : mine; }
        if (sum == G) break;
        __builtin_amdgcn_s_sleep(1);
        if ((++sp & 255u) == 0u) { if (xb_ld(&bar[XB_TMO])) break; if (sp > XB_SPIN_CAP) { atomicAdd(&bar[XB_TMO], 1u); break; } }
    }
    nloc = mine > 0u ? mine : 1u; nx = cnt > 0u ? cnt : 1u;
}

__device__ __forceinline__ void xcd_barrier(const XcdBarrier& b) {
    asm volatile("s_waitcnt vmcnt(0)" ::: "memory");
    __syncthreads();
    if (threadIdx.x == 0) {
        unsigned* bar = b.bar;
        __builtin_amdgcn_s_waitcnt(0);
        unsigned nloc = b.st[0], nx = b.st[1];
        if (nloc == 0u) { xcd_barrier_complete(bar, b.x, nloc, nx); b.st[0] = nloc; b.st[1] = nx; }
        const unsigned old = xb_add(&bar[XB_XSUB(b.x)], 1u);
        const unsigned gen = old / nloc;
        if (old + 1u == (gen + 1u) * nloc) {
            __builtin_amdgcn_fence(__ATOMIC_RELEASE, "agent");
            asm volatile("s_waitcnt vmcnt(0)" ::: "memory");
            const unsigned og = xb_add(&bar[XB_TOP], 1u);
            const unsigned tg = og / nx;
            if (og + 1u == (tg + 1u) * nx) xb_add(&bar[XB_TOPGEN], 1u);
            else XB_SPIN(xb_ld(&bar[XB_TOPGEN]) == tg, bar);
            __builtin_amdgcn_fence(__ATOMIC_ACQUIRE, "agent");
            xb_add(&bar[XB_XGEN(b.x)], 1u);
            asm volatile("s_waitcnt vmcnt(0)" ::: "memory");
        } else {
            XB_SPIN(xb_ld(&bar[XB_XGEN(b.x)]) == gen, bar);
            __builtin_amdgcn_fence(__ATOMIC_ACQUIRE, "agent");
            asm volatile("s_waitcnt vmcnt(0)" ::: "memory");
        }
    }
    __syncthreads();
}

struct Args { const void* in[21]; float* out; unsigned char* ws; int ph_lo, ph_hi; };
constexpr int N_PHASES = 13;
#ifndef DUP_PHASE
#define DUP_PHASE (-1)
#endif

#define REPS(k) for (int rep_ = 0; rep_ < (((k) == DUP_PHASE) ? 2 : 1); ++rep_)

__global__ void __launch_bounds__(NTHREADS, 2) fwd_kernel(Args args) {
    extern __shared__ __attribute__((aligned(16))) unsigned char lds_raw[];
    LAS unsigned char* lds = (LAS unsigned char*)lds_raw;
    cg::grid_group grid = cg::this_grid();
    const int wave = __builtin_amdgcn_readfirstlane(threadIdx.x >> 6);
    const int G = gridDim.x, bx = blockIdx.x;
    const int gw = bx * 8 + wave, ngw = G * 8;
    const int lo = args.ph_lo, hi_ = args.ph_hi;
#define IN(k) (lo <= (k) && (k) < hi_)
#define SEAM(k) do { if (IN(k) && IN((k) + 1)) xcd_barrier(bar); } while (0)
    const float* x_in = (const float*)args.in[0]; const float* mem = (const float*)args.in[1]; const int* positions = (const int*)args.in[2];
    const float* mix_norm = (const float*)args.in[3]; const float* mlp_norm = (const float*)args.in[4]; const float* mem_norm = (const float*)args.in[5]; const float* final_norm = (const float*)args.in[6];
    const float* w_mem_kv = (const float*)args.in[7]; const float* w_out = (const float*)args.in[8]; const float* w_up = (const float*)args.in[9]; const float* w_down = (const float*)args.in[10];
    const float* attn_w_in = (const float*)args.in[11]; const float* attn_sinks = (const float*)args.in[12]; const float* lru_w_in = (const float*)args.in[13];
    const float* lru_conv_w = (const float*)args.in[14]; const float* lru_conv_b = (const float*)args.in[15]; const float* lru_wa = (const float*)args.in[16]; const float* lru_ba = (const float*)args.in[17];
    const float* lru_wx = (const float*)args.in[18]; const float* lru_bx = (const float*)args.in[19]; const float* lru_lambda = (const float*)args.in[20];
    unsigned char* ws = args.ws; float* X = args.out;
    unsigned* barw = (unsigned*)(ws + WS_BAR);
    volatile LAS unsigned* bst = (volatile LAS unsigned*)(lds + LDS_BYTES - 64);
    if (threadIdx.x == 0) { bst[0] = 0u; bst[1] = 0u; }
    __syncthreads();
    XcdBarrier bar; bar.bar = barw; bar.x = 0; bar.st = bst;
    if (args.ph_lo < 0) grid.sync();
    if (args.ph_hi - args.ph_lo > 1) bar = xcd_barrier_post(barw, bst);
    float* SS = (float*)(ws + WS_SS); float* ROPE = (float*)(ws + WS_ROPE); float* SUM = (float*)(ws + WS_SUM);
    bf16_t* KM = (bf16_t*)(ws + WS_KM); bf16_t* VMT = (bf16_t*)(ws + WS_VMT); bf16_t* MEMN = (bf16_t*)(ws + WS_MEMN);
    bf16_t* W_AIN = (bf16_t*)(ws + WS_W_AIN); bf16_t* W_LIN = (bf16_t*)(ws + WS_W_LIN); bf16_t* W_MKV = (bf16_t*)(ws + WS_W_MKV); bf16_t* W_GATE = (bf16_t*)(ws + WS_W_GATE);
    bf16_t* VT = (bf16_t*)(ws + WS_VT); bf16_t* XB = (bf16_t*)(ws + WS_XB); bf16_t* CAB = (bf16_t*)(ws + WS_CAB); bf16_t* PB = (bf16_t*)(ws + WS_P); bf16_t* MIX = (bf16_t*)(ws + WS_MIX); bf16_t* HB = (bf16_t*)(ws + WS_H);

    if (IN(0)) REPS(0) {
        const int lane = opaque_lane(), tid = wave * 64 + lane;
        for (int i = bx * NTHREADS + tid; i < 4 * T; i += G * NTHREADS) SS[i] = 0.f;
        for (int i = bx * NTHREADS + tid; i < T * 8; i += G * NTHREADS) {
            const int tok = i >> 3, f = i & 7;
            const float invf = (f == 0) ? 1.0f : (f == 1) ? 0.1939227432012558f : (f == 2) ? 0.03760603070259094f : (f == 3) ? 0.007292664609849453f : (f == 4) ? 0.0014142135623842478f
                             : (f == 5) ? 0.00027424818836152554f : (f == 6) ? 5.3182957344688475e-05f : 1.0313385246263351e-05f;
            const float ang = (float)positions[tok] * invf; float sn, cs; sincosf(ang, &sn, &cs);
            ROPE[(size_t)tok * 16 + f] = cs; ROPE[(size_t)tok * 16 + 8 + f] = sn;
        }
        LAS float* scr = (LAS float*)(lds + wave * TP_BYTES);
        {
            constexpr int I_AIN = (DM / 64) * (AIN / 64), I_LIN = (DM / 64) * (LIN / 64), I_OUT = (MIXW / 64) * (DM / 64), I_UP = (DM / 64) * (DFF / 64), I_DN = (DFF / 64) * (DM / 64), I_MKV = (DM / 64) * (1024 / 64), I_GATE = 128;
            constexpr int I_TOTAL = I_AIN + I_LIN + 2 * (I_OUT + I_UP + I_DN + I_MKV) + I_GATE;
            for (int it = gw; it < I_TOTAL; it += ngw) {
                int r = it;
                if (r < I_AIN) { transpose_tile64(attn_w_in, AIN, 64 * (r / (AIN / 64)), 64 * (r % (AIN / 64)), W_AIN, DM, nullptr, -1, scr, lane); continue; } r -= I_AIN;
                if (r < I_LIN) { transpose_tile64(lru_w_in, LIN, 64 * (r / (LIN / 64)), 64 * (r % (LIN / 64)), W_LIN, DM, mix_norm + DM, -1, scr, lane); continue; } r -= I_LIN;
                bool done = false;
#pragma unroll
                for (int l = 0; l < 2; ++l) {
                    if (done) break;
                    if (r < I_OUT) { transpose_tile64(w_out + (size_t)l * MIXW * DM, DM, 64 * (r / (DM / 64)), 64 * (r % (DM / 64)), (bf16_t*)(ws + (l ? WS_W_OUT1 : WS_W_OUT0)), MIXW, nullptr, -1, scr, lane); done = true; break; } r -= I_OUT;
                    if (r < I_UP) { transpose_tile64(w_up + (size_t)l * DM * DFF, DFF, 64 * (r / (DFF / 64)), 64 * (r % (DFF / 64)), (bf16_t*)(ws + (l ? WS_W_UP1 : WS_W_UP0)), DM, mlp_norm + l * DM, -1, scr, lane); done = true; break; } r -= I_UP;
                    if (r < I_DN) { transpose_tile64(w_down + (size_t)l * DFF * DM, DM, 64 * (r / (DM / 64)), 64 * (r % (DM / 64)), (bf16_t*)(ws + (l ? WS_W_DN1 : WS_W_DN0)), DFF, nullptr, -1, scr, lane); done = true; break; } r -= I_DN;
                    if (r < I_MKV) { transpose_tile64(w_mem_kv + (size_t)l * DM * 1024, 1024, 64 * (r / 16), 64 * (r % 16), W_MKV + (size_t)l * 1024 * DM, DM, nullptr, -1, scr, lane); done = true; break; } r -= I_MKV;
                }
                if (done) continue;
                {
                    const int n = r >> 4, g = (r >> 2) & 3, kb = (r >> 1) & 1, nb = r & 1;
                    const float* W = ((g & 1) ? lru_wx : lru_wa) + ((size_t)((g >> 1) * 8 + n)) * 128 * 128;
                    transpose_tile64(W, 128, 64 * kb, 64 * nb, W_GATE + (size_t)n * 512 * 128, 128, nullptr, g, scr, lane);
                }
            }
        }
        for (int m = gw; m < 1024; m += ngw) rms_row_to_bf16(mem + (size_t)m * DM, mem_norm, MEMN + (size_t)m * DM, lane);
        for (int m = gw * 4; m < T; m += ngw * 4) rms_rows4_to_bf16(x_in + (size_t)m * DM, mix_norm, XB + (size_t)m * DM, lane);
    }
    SEAM(0);
#pragma nounroll
    for (int layer = 0; layer < 2; ++layer) {
        const int pb = layer ? 6 : 1;
        if (IN(pb)) REPS(pb) {
            if (layer == 0) {
                { pg8::Gemm g{XB, W_AIN, T, AIN, DM}; pg8::StaticOrder S; S.init(T, AIN, G, bx); EpiInL0 E{PB, VT, ROPE};

#ifndef NO_EpiInL0
pg8::gemm_phase<EpiInL0, pg8::StaticOrder, true, true>(lds, g, S, E, wave);
#endif
 }
                { pg8::Gemm g{MEMN, W_MKV, 1024, 2048, DM}; pg8::StaticOrder S; S.init(1024, 2048, G, bx); EpiMemKV E{KM, VMT};

#ifndef NO_EpiMemKV
pg8::gemm_phase<EpiMemKV, pg8::StaticOrder, true, true>(lds, g, S, E, wave);
#endif
 }
            } else {
                pg8::Gemm g{XB, W_LIN, T, LIN, DM}; pg8::StaticOrder S; S.init(T, LIN, G, bx); EpiInL1 E{PB, SS + 1 * T};

#ifndef NO_EpiInL1
pg8::gemm_phase<EpiInL1, pg8::StaticOrder, true, true>(lds, g, S, E, wave);
#endif

            }
        }
        SEAM(pb);
        if (IN(pb + 1)) REPS(pb + 1) {
            if (layer == 0) {
                for (int uidx = bx; uidx < 1024 + 256; uidx += G) {
                    if (uidx < 1024) { const int kvh = uidx & 3, nblk = (uidx >> 2) & 63, b = uidx >> 8;
#ifndef NO_WATTN
 wattn_unit(lds, PB, VT, MIX, attn_sinks, b, nblk, kvh, wave);
#endif
 }
                    else { const int v = uidx - 1024, hm = v & 3, qblk = (v >> 2) & 15, b = v >> 6;
#ifndef NO_MATTN
 mattn_unit(lds, PB, AIN, 1536, KM, VMT, MIX, 0, b, hm, qblk, wave);
#endif
 }
                }
            } else {
                LruP L{PB, lru_conv_w, lru_conv_b, lru_ba, lru_bx, lru_lambda, W_GATE, (bf16_t*)X, CAB, MIX, SUM};
                lru_units(lds, L, bx, G, wave);
                for (int v = bx; v < 256; v += G) { const int hm = v & 3, qblk = (v >> 2) & 15, b = v >> 6; mattn_unit(lds, PB, LIN, 2048, KM, VMT, MIX, 1, b, hm, qblk, wave); }
            }
        }
        SEAM(pb + 1);
        if (layer == 1) {
            if (IN(8)) { for (int uidx = bx; uidx < 256; uidx += G) lru_fix_unit(lds, SUM, (const bf16_t*)X, CAB, PB, MIX, uidx >> 6, uidx & 63, wave); }
            SEAM(8);
        }
        const int po = layer ? 9 : 3;
        if (IN(po)) {
            pg8::Gemm g{MIX, (const bf16_t*)(ws + (layer ? WS_W_OUT1 : WS_W_OUT0)), T, DM, MIXW}; pg8::StaticOrder S; S.init(T, DM, G, bx);
            if (layer == 0) { EpiRes<false> E{x_in, XB, SS + 0 * T, (LAS float*)(lds + pg8::STAGE_BYTES)}; pg8::gemm_phase<EpiRes<false>, pg8::StaticOrder, true, true>(lds, g, S, E, wave); }
            else { EpiRes<true> E{XB, XB, SS + 2 * T, (LAS float*)(lds + pg8::STAGE_BYTES)}; pg8::gemm_phase<EpiRes<true>, pg8::StaticOrder, true, true>(lds, g, S, E, wave); }
        }
        SEAM(po);
        if (IN(po + 1)) REPS(po + 1) {
            pg8::Gemm g{XB, (const bf16_t*)(ws + (layer ? WS_W_UP1 : WS_W_UP0)), T, DFF, DM}; pg8::StaticOrder S; S.init(T, DFF, G, bx);
            EpiUp E{HB, SS + (layer ? 2 : 0) * T};

#ifndef NO_EpiUp
pg8::gemm_phase<EpiUp, pg8::StaticOrder, true, true>(lds, g, S, E, wave);
#endif

        }
        SEAM(po + 1);
        if (IN(po + 2)) {
            pg8::Gemm g{HB, (const bf16_t*)(ws + (layer ? WS_W_DN1 : WS_W_DN0)), T, DM, DFF}; RevRounds S; S.init(T, DM, G, bx);
            EpiRes<true> E{XB, XB, SS + (layer ? 3 : 1) * T, (LAS float*)(lds + pg8::STAGE_BYTES)};
            pg8::gemm_phase<EpiRes<true>, RevRounds, true, true>(lds, g, S, E, wave);
        }
        SEAM(po + 2);
    }
    if (IN(12)) {
        const int lane = opaque_lane();
        const float* ss = SS + 3 * T;
        f32x4 gg[2][2];
#pragma unroll
        for (int j = 0; j < 2; ++j) { gg[j][0] = *(const f32x4*)(final_norm + (lane + 64 * j) * 8); gg[j][1] = *(const f32x4*)(final_norm + (lane + 64 * j) * 8 + 4); }
        for (int m0 = gw * 4; m0 < T; m0 += ngw * 4) {
            u32x4 w[4][2]; float rs[4];
#pragma unroll
            for (int i = 0; i < 4; ++i) { rs[i] = rsqrtf(ss[m0 + i] * (1.f / DM) + EPS);
#pragma unroll
                for (int j = 0; j < 2; ++j) w[i][j] = __builtin_nontemporal_load((const u32x4*)(XB + (size_t)(m0 + i) * DM + (lane + 64 * j) * 8)); }
#pragma unroll
            for (int i = 0; i < 4; ++i)
#pragma unroll
                for (int j = 0; j < 2; ++j) { f32x4 a0, a1; unpack8(w[i][j], a0, a1); float* op = X + (size_t)(m0 + i) * DM + (lane + 64 * j) * 8;
                    __builtin_nontemporal_store(a0 * rs[i] * gg[j][0], (f32x4*)op); __builtin_nontemporal_store(a1 * rs[i] * gg[j][1], (f32x4*)(op + 4)); }
        }
    }
#undef IN
#undef SEAM
}

#ifndef MK_N_LAUNCHES
#define MK_N_LAUNCHES 1
#endif
extern "C" void kernel_launch(void* const* d_in, const int* in_sizes, int n_in, void* d_out, int out_size, void* d_ws, size_t ws_size, hipStream_t stream) {
    static int grid = 0;
    if (grid == 0) {
        if (n_in != 21 || in_sizes[0] != T * DM || out_size != T * DM || ws_size < WS_END) {
            fprintf(stderr, "kernel_launch: unexpected problem: n_in %d in0 %d out %d ws %zu (need %zu)\n", n_in, n_in > 0 ? in_sizes[0] : -1, out_size, ws_size, (size_t)WS_END); grid = -1; return; }
        int dev = 0, cus = 0, per_cu = 0;
        if (hipGetDevice(&dev) != hipSuccess || hipDeviceGetAttribute(&cus, hipDeviceAttributeMultiprocessorCount, dev) != hipSuccess) { fprintf(stderr, "kernel_launch: device query failed\n"); grid = -1; return; }
        if (hipFuncSetAttribute((const void*)fwd_kernel, hipFuncAttributeMaxDynamicSharedMemorySize, LDS_BYTES) != hipSuccess) { fprintf(stderr, "kernel_launch: hipFuncSetAttribute failed\n"); grid = -1; return; }
        if (hipOccupancyMaxActiveBlocksPerMultiprocessor(&per_cu, (const void*)fwd_kernel, NTHREADS, LDS_BYTES) != hipSuccess || per_cu < 1) { fprintf(stderr, "kernel_launch: occupancy query gave %d\n", per_cu); per_cu = 1; }
        (void)hipGetLastError();
        grid = cus;
        fprintf(stderr, "kernel_launch: grid %d (cus %d, per_cu %d)\n", grid, cus, per_cu);
    }
    if (grid < 0) return;
    Args a{};
    for (int i = 0; i < 21; ++i) a.in[i] = d_in[i];
    a.out = (float*)d_out; a.ws = (unsigned char*)d_ws;
#if MK_N_LAUNCHES == 1
    a.ph_lo = 0; a.ph_hi = N_PHASES;
    if (hipMemsetAsync((char*)d_ws + WS_BAR, 0, XCD_BAR_WORDS * 4, stream) != hipSuccess) { fprintf(stderr, "kernel_launch: memset of the barrier words failed\n"); return; }
    void* kargs[] = {&a};
    hipError_t e = hipLaunchCooperativeKernel((const void*)fwd_kernel, dim3(grid), dim3(NTHREADS), kargs, LDS_BYTES, stream);
    if (e != hipSuccess) fprintf(stderr, "kernel_launch: cooperative launch failed: %s (grid %d)\n", hipGetErrorString(e), grid);
#else
    for (int p = 0; p < N_PHASES; ++p) {
        a.ph_lo = p; a.ph_hi = p + 1;
        hipLaunchKernelGGL(fwd_kernel, dim3(grid), dim3(NTHREADS), LDS_BYTES, stream, a);
    }
#endif
}
```

```cpp
#include <hip/hip_runtime.h>
#include <hip/hip_cooperative_groups.h>
#include <cstdio>
#include <cstdint>
namespace cg = cooperative_groups;
namespace pg8 {
#define PG8_LAS __attribute__((address_space(3)))
typedef unsigned short bf16_t;
typedef short bf16x8 __attribute__((ext_vector_type(8)));
typedef float f32x4 __attribute__((ext_vector_type(4)));
typedef unsigned u32x4 __attribute__((ext_vector_type(4)));
constexpr int BM = 256, BK = 64, HALF = 128, HTB = HALF * BK * 2  , STAGE_BYTES = 8 * HTB, NXCD = 8, WGM = 8;

__host__ __device__ __forceinline__ int lds_byte(int r, int c) { const int st = (r >> 4) * 2 + (c >> 5), rr = r & 15, cc = c & 31, ob = rr * 64 + cc * 2; return st * 1024 + (ob ^ (((ob >> 9) & 1) << 5)); }
__host__ __device__ __forceinline__ void stage_rc(int b, int& R, int& C) { const int st = b / 1024, sb = b % 1024, swz = sb ^ (((sb >> 9) & 1) << 5); R = (st >> 1) * 16 + swz / 64; C = (st & 1) * 32 + (swz % 64) / 2; }
__host__ __device__ __forceinline__ int perm32(int rho) { const int n = rho >> 4, i = rho & 15; return 8 * (i >> 2) + 4 * n + (i & 3); }

struct Unit { int pm, pn; };
struct Gemm { const bf16_t* A; const bf16_t* Bt; int M, N, K; };

struct StaticOrder {
    int nM, nN, nwg, G, c;
    __host__ __device__ void init(int M, int N, int G_, int c_) { nM = M / BM; nN = N / BM; nwg = nM * nN; G = G_; c = c_; }
    __host__ __device__ bool next(int i, Unit& u) const {
        const long L = (long)i * G + c; if (L >= nwg) return false;
        int wgid = (int)L; { const int q = nwg / NXCD, r = nwg % NXCD, xcd = wgid % NXCD, off = wgid / NXCD; wgid = (xcd < r ? xcd * (q + 1) : r * (q + 1) + (xcd - r) * q) + off; }
        const int nig = WGM * nN, gid = wgid / nig, fm = gid * WGM, gsz = (nM - fm) < WGM ? (nM - fm) : WGM;
        u.pm = fm + ((wgid % nig) % gsz); u.pn = (wgid % nig) / gsz; return true;
    }
    __device__ __forceinline__ void a_ready(const Unit&) const {}
    __device__ __forceinline__ void done(const Unit&) const {}
};

__device__ __forceinline__ unsigned cvt_pk_bf16(float lo, float hi) { unsigned r; asm volatile("v_cvt_pk_bf16_f32 %0, %1, %2" : "=v"(r) : "v"(lo), "v"(hi)); return r; }
template <class Epi, class Sched, bool ALIGN_EPI = false, bool SP2 = false>
__device__ __forceinline__ void gemm_phase(PG8_LAS unsigned char* lds, const Gemm g, const Sched& S, const Epi& E, const int wave_s) {
    int lane_; asm volatile("v_mbcnt_lo_u32_b32 %0, -1, 0\n\tv_mbcnt_hi_u32_b32 %0, -1, %0" : "=v"(lane_));
    const int tid = wave_s * 64 + lane_, wid = __builtin_amdgcn_readfirstlane(tid >> 6), lane = tid & 63, wr = wid >> 2, wc = wid & 3, fr = lane & 15, fq = lane >> 4;
    const int K = g.K, nt = K / BK;
    unsigned voffA[2], voffB[2];
#pragma unroll
    for (int i = 0; i < 2; ++i) { int R, C; stage_rc(tid * 16 + i * 8192, R, C); const int Rb = Epi::PERM ? ((R & ~31) + perm32(R & 31)) : R;
        voffA[i] = (unsigned)(R * K + C) * 2u; voffB[i] = (unsigned)(Rb * K + C) * 2u; }
    const size_t kstep = (size_t)(BK * 2);
    const size_t hstep = (size_t)HALF * K * 2;
    const size_t tstep = 2 * hstep;
    const unsigned ldsw = (unsigned)wid * 1024u;
    const int aoff = lds_byte(wr * 64 + fr, fq * 8), boff = lds_byte(wc * 32 + fr, fq * 8);
#define PG8_SA(b, h) (((b) * 2 + (h)) * HTB)
#define PG8_SB(b, h) ((4 + (b) * 2 + (h)) * HTB)
#define PG8_STAGE(bufoff, gbase, voff) do { _Pragma("unroll") for (int _i = 0; _i < 2; ++_i) \
        __builtin_amdgcn_global_load_lds((const unsigned*)((const char*)(gbase) + (voff)[_i]), (PG8_LAS unsigned*)(lds + (bufoff) + ldsw + _i * 8192), 16, 0, 0); } while (0)
#define PG8_LDA(dst, b, h) do { _Pragma("unroll") for (int m = 0; m < 4; ++m) _Pragma("unroll") for (int k = 0; k < 2; ++k) dst[m][k] = *(const PG8_LAS bf16x8*)(lds + PG8_SA(b, h) + aoff + m * 2048 + k * 1024); } while (0)
#define PG8_LDB(dst, b, h) do { _Pragma("unroll") for (int n = 0; n < 2; ++n) _Pragma("unroll") for (int k = 0; k < 2; ++k) dst[n][k] = *(const PG8_LAS bf16x8*)(lds + PG8_SB(b, h) + boff + n * 2048 + k * 1024); } while (0)
#define PG8_MMA(ai, bj, At, Bt) do { __builtin_amdgcn_s_setprio(1); _Pragma("unroll") for (int m = 0; m < 4; ++m) _Pragma("unroll") for (int n = 0; n < 2; ++n) _Pragma("unroll") for (int k = 0; k < 2; ++k) \
        acc[ai][bj][m][n] = __builtin_amdgcn_mfma_f32_16x16x32_bf16(Bt[n][k], At[m][k], acc[ai][bj][m][n], 0, 0, 0); __builtin_amdgcn_s_setprio(0); } while (0)
#define PG8_WAIT_V(n) asm volatile("s_waitcnt vmcnt(" #n ")" ::: "memory")
#define PG8_WAIT_L(n) asm volatile("s_waitcnt lgkmcnt(" #n ")" ::: "memory")
#define PG8_BAR __builtin_amdgcn_s_barrier()
#define PG8_SCHED __builtin_amdgcn_sched_barrier(0)
    Unit cur, nxt; int ui = 0;
    if (!S.next(0, cur)) return;
    f32x4 acc[2][2][4][2];
#pragma unroll
    for (int a = 0; a < 2; ++a)
#pragma unroll
        for (int b = 0; b < 2; ++b)
#pragma unroll
            for (int m = 0; m < 4; ++m)
#pragma unroll
                for (int n = 0; n < 2; ++n) acc[a][b][m][n] = (f32x4){0.f, 0.f, 0.f, 0.f};
    bf16x8 At[4][2], B0[2][2], B1[2][2];
    const char* cA = (const char*)g.A + (size_t)cur.pm * tstep; const char* cB = (const char*)g.Bt + (size_t)cur.pn * tstep;
    S.a_ready(cur);
    if constexpr (SP2) {
        PG8_STAGE(PG8_SB(0, 0), cB, voffB); PG8_STAGE(PG8_SB(0, 1), cB + hstep, voffB); PG8_STAGE(PG8_SA(0, 0), cA, voffA); PG8_STAGE(PG8_SA(0, 1), cA + hstep, voffA);
        if (wr == 1) PG8_BAR;
        PG8_WAIT_V(2); PG8_BAR;
        PG8_STAGE(PG8_SB(1, 0), cB + kstep, voffB); PG8_STAGE(PG8_SA(1, 0), cA + kstep, voffA); PG8_STAGE(PG8_SB(1, 1), cB + hstep + kstep, voffB);
        PG8_WAIT_V(6); PG8_BAR;
    } else {
        PG8_STAGE(PG8_SB(0, 0), cB, voffB); PG8_STAGE(PG8_SA(0, 0), cA, voffA); PG8_STAGE(PG8_SB(0, 1), cB + hstep, voffB); PG8_STAGE(PG8_SA(0, 1), cA + hstep, voffA);
        if (wr == 1) PG8_BAR;
        PG8_WAIT_V(4); PG8_BAR;
        PG8_STAGE(PG8_SB(1, 0), cB + kstep, voffB); PG8_STAGE(PG8_SA(1, 0), cA + kstep, voffA); PG8_STAGE(PG8_SB(1, 1), cB + hstep + kstep, voffB);
        PG8_WAIT_V(6); PG8_BAR;
    }
    for (;;) {
        const bool has_next = S.next(ui + 1, nxt);
        const char* nA = has_next ? (const char*)g.A + (size_t)nxt.pm * tstep : cA; const char* nB = has_next ? (const char*)g.Bt + (size_t)nxt.pn * tstep : cB;
        for (int t = 0; t < nt; t += 2) {
            const bool last = (t == nt - 2);
            const char* a1 = cA + (size_t)(t + 1) * kstep;
            const char* a2 = last ? nA : cA + (size_t)(t + 2) * kstep; const char* b2 = last ? nB : cB + (size_t)(t + 2) * kstep;
            const char* a3 = a2 + kstep; const char* b3 = b2 + kstep;
            if (last && has_next) S.a_ready(nxt);
            if constexpr (SP2) {
            PG8_LDB(B0, 0, 0); PG8_LDB(B1, 0, 1); PG8_SCHED; PG8_LDA(At, 0, 0); PG8_STAGE(PG8_SA(1, 1), a1 + hstep, voffA);
            PG8_WAIT_V(8); PG8_WAIT_L(0); PG8_BAR; PG8_MMA(0, 0, At, B0); PG8_MMA(0, 1, At, B1); PG8_BAR; PG8_SCHED;
            PG8_LDA(At, 0, 1); PG8_STAGE(PG8_SB(0, 0), b2, voffB); PG8_STAGE(PG8_SB(0, 1), b2 + hstep, voffB); PG8_STAGE(PG8_SA(0, 0), a2, voffA);
            PG8_WAIT_V(8); PG8_WAIT_L(0); PG8_BAR; PG8_MMA(1, 0, At, B0); PG8_MMA(1, 1, At, B1); PG8_BAR; PG8_SCHED;
            PG8_LDB(B0, 1, 0); PG8_LDB(B1, 1, 1); PG8_SCHED; PG8_LDA(At, 1, 0); PG8_STAGE(PG8_SA(0, 1), a2 + hstep, voffA);
            PG8_WAIT_V(8); PG8_WAIT_L(0); PG8_BAR; PG8_MMA(0, 0, At, B0); PG8_MMA(0, 1, At, B1); PG8_BAR; PG8_SCHED;
            PG8_LDA(At, 1, 1); PG8_STAGE(PG8_SB(1, 0), b3, voffB); PG8_STAGE(PG8_SB(1, 1), b3 + hstep, voffB); PG8_STAGE(PG8_SA(1, 0), a3, voffA);
            PG8_WAIT_V(8); PG8_WAIT_L(0); PG8_BAR; PG8_MMA(1, 0, At, B0); PG8_MMA(1, 1, At, B1); PG8_BAR; PG8_SCHED;
            } else {
            PG8_LDB(B0, 0, 0); PG8_SCHED; PG8_LDA(At, 0, 0); PG8_STAGE(PG8_SA(1, 1), a1 + hstep, voffA);
            PG8_WAIT_L(8); PG8_BAR; PG8_WAIT_L(0); PG8_MMA(0, 0, At, B0); PG8_BAR; PG8_SCHED;
            PG8_LDB(B1, 0, 1); PG8_STAGE(PG8_SB(0, 0), b2, voffB);
            PG8_BAR; PG8_WAIT_L(0); PG8_MMA(0, 1, At, B1); PG8_BAR;
            PG8_LDA(At, 0, 1); PG8_STAGE(PG8_SA(0, 0), a2, voffA);
            PG8_BAR; PG8_WAIT_L(0); PG8_MMA(1, 0, At, B0); PG8_BAR; PG8_SCHED;
            PG8_STAGE(PG8_SB(0, 1), b2 + hstep, voffB);
            PG8_WAIT_V(6); PG8_BAR; PG8_MMA(1, 1, At, B1); PG8_BAR;
            PG8_LDB(B0, 1, 0); PG8_SCHED; PG8_LDA(At, 1, 0); PG8_STAGE(PG8_SA(0, 1), a2 + hstep, voffA);
            PG8_WAIT_L(8); PG8_BAR; PG8_WAIT_L(0); PG8_MMA(0, 0, At, B0); PG8_BAR; PG8_SCHED;
            PG8_LDB(B1, 1, 1); PG8_STAGE(PG8_SB(1, 0), b3, voffB);
            PG8_BAR; PG8_WAIT_L(0); PG8_MMA(0, 1, At, B1); PG8_BAR;
            PG8_LDA(At, 1, 1); PG8_STAGE(PG8_SA(1, 0), a3, voffA);
            PG8_BAR; PG8_WAIT_L(0); PG8_MMA(1, 0, At, B0); PG8_BAR; PG8_SCHED;
            PG8_STAGE(PG8_SB(1, 1), b3 + hstep, voffB);
            PG8_WAIT_V(6); PG8_BAR; PG8_MMA(1, 1, At, B1); PG8_BAR;
            }
        }
        if constexpr (ALIGN_EPI) { if (wr == 0) PG8_BAR; }
        if constexpr (!Epi::AFTER_DRAIN) { E(acc, cur, wr, wc, fr, fq); S.done(cur); }
        if (!has_next) break;
#pragma unroll
        for (int a = 0; a < 2; ++a)
#pragma unroll
            for (int b = 0; b < 2; ++b)
#pragma unroll
                for (int m = 0; m < 4; ++m)
#pragma unroll
                    for (int n = 0; n < 2; ++n) acc[a][b][m][n] = (f32x4){0.f, 0.f, 0.f, 0.f};
        cur = nxt; cA = nA; cB = nB; ++ui;
        if constexpr (ALIGN_EPI) { if (wr == 1) PG8_BAR; }
    }
    PG8_WAIT_V(0);
    if constexpr (!ALIGN_EPI) { if (wr == 0) PG8_BAR; }
    PG8_BAR;
    if constexpr (Epi::AFTER_DRAIN) { E.fused(acc, cur, wr, wc, fr, fq, lds, wid, lane); S.done(cur); }
#undef PG8_SA
#undef PG8_SB
#undef PG8_STAGE
#undef PG8_LDA
#undef PG8_LDB
#undef PG8_MMA
#undef PG8_WAIT_V
#undef PG8_WAIT_L
#undef PG8_BAR
#undef PG8_SCHED
}
}

constexpr int NB = 4, SEQ = 8192, T = NB * SEQ, DM = 1024, DFF = 4096;
constexpr int AIN = 2048, LIN = 2560, MIXW = 1536;
constexpr float EPS = 1e-6f;
constexpr float LOG2E = 1.4426950408889634f;
constexpr int NTHREADS = 512;
constexpr int LDS_BYTES = 147456;

constexpr size_t MiB = 1u << 20;
constexpr size_t WS_SS = 0;
constexpr size_t WS_BAR = 768 * 1024;
constexpr size_t WS_ROPE = 1 * MiB;
constexpr size_t WS_SUM = 3 * MiB;
constexpr size_t WS_KM = 7 * MiB;
constexpr size_t WS_VMT = 9 * MiB;
constexpr size_t WS_MEMN = 11 * MiB;
constexpr size_t WS_W_AIN = 16 * MiB, WS_W_LIN = 20 * MiB, WS_W_OUT0 = 25 * MiB, WS_W_OUT1 = 28 * MiB, WS_W_UP0 = 31 * MiB, WS_W_UP1 = 39 * MiB,
                 WS_W_DN0 = 47 * MiB, WS_W_DN1 = 55 * MiB, WS_W_MKV = 63 * MiB, WS_W_GATE = 67 * MiB;
constexpr size_t WS_VT = 68 * MiB;
constexpr size_t WS_XB = 84 * MiB;
constexpr size_t WS_CAB = 148 * MiB;
constexpr size_t WS_P = 212 * MiB;
constexpr size_t WS_MIX = 372 * MiB;
constexpr size_t WS_H = 212 * MiB;
constexpr size_t WS_END = 468 * MiB;

using pg8::bf16_t; using pg8::bf16x8; using pg8::f32x4; using pg8::u32x4; using pg8::cvt_pk_bf16;
#define LAS __attribute__((address_space(3)))
typedef float f32x16 __attribute__((ext_vector_type(16)));
typedef short s16x4 __attribute__((ext_vector_type(4)));
typedef unsigned u32x2 __attribute__((ext_vector_type(2)));

__device__ __forceinline__ float bf2f(unsigned short h) { return __uint_as_float((unsigned)h << 16); }
__device__ __forceinline__ unsigned short f2bf(float f) { unsigned u = __float_as_uint(f); return (unsigned short)((u + 0x7fffu + ((u >> 16) & 1u)) >> 16); }
__device__ __forceinline__ u32x4 pack8(f32x4 a, f32x4 b) { u32x4 w; w.x = cvt_pk_bf16(a[0], a[1]); w.y = cvt_pk_bf16(a[2], a[3]); w.z = cvt_pk_bf16(b[0], b[1]); w.w = cvt_pk_bf16(b[2], b[3]); return w; }
__device__ __forceinline__ int crow(int r, int hi) { return (r & 3) + 8 * (r >> 2) + 4 * hi; }
__device__ __forceinline__ float fast_exp2(float x) { return __builtin_amdgcn_exp2f(x); }
__device__ __forceinline__ float fast_rcp(float x) { return __builtin_amdgcn_rcpf(x); }
__device__ __forceinline__ float sigmoidf_(float z) { return fast_rcp(1.f + fast_exp2(-z * LOG2E)); }
__device__ __forceinline__ float gelu_tanh(float x) { const float y = 0.7978845608028654f * (x + 0.044715f * x * x * x); const float t = fast_exp2(2.f * LOG2E * y); return x * (1.f - fast_rcp(t + 1.f)); }
__device__ __forceinline__ int opaque_lane() { int l; asm volatile("v_mbcnt_lo_u32_b32 %0, -1, 0\n\tv_mbcnt_hi_u32_b32 %0, -1, %0" : "=v"(l)); return l; }
__device__ __forceinline__ float wave_sum(float v) {
#pragma unroll
    for (int o = 1; o < 64; o <<= 1) v += __shfl_xor(v, o);
    return v;
}

struct EpiInL0 {
    static constexpr bool PERM = true, AFTER_DRAIN = false;
    bf16_t* P; bf16_t* VT; const float* rope;
    __device__ __forceinline__ void operator()(const f32x4 (&acc)[2][2][4][2], const pg8::Unit& u, int wr, int wc, int fr, int fq) const {
        asm volatile("" : "+v"(fr), "+v"(fq));
        const int pn = u.pn;
        const bool rot = (pn < 5) && ((wc & 1) == 0);
#pragma unroll
        for (int ai = 0; ai < 2; ++ai) {
            f32x4 rp_[4][4];
            if (rot && fq < 2) {
#pragma unroll
                for (int m = 0; m < 4; ++m) { const float* rp = rope + (size_t)(u.pm * 256 + ai * 128 + wr * 64 + m * 16 + fr) * 16;
#pragma unroll
                    for (int j = 0; j < 4; ++j) rp_[m][j] = *(const f32x4*)(rp + 4 * j); }
            }
            asm volatile("" ::: "memory");
#pragma unroll
            for (int m = 0; m < 4; ++m) {
                const int row = u.pm * 256 + ai * 128 + wr * 64 + m * 16 + fr;
#pragma unroll
                for (int bj = 0; bj < 2; ++bj) {
                    const int c0 = pn * 256 + bj * 128 + wc * 32 + 8 * fq;
                    f32x4 v0 = acc[ai][bj][m][0], v1 = acc[ai][bj][m][1];
                    if (pn == 5) {
                        const int cc = c0 - 1280, kvh = cc >> 6, d = cc & 63, b = row >> 13, s = row & (SEQ - 1);
                        bf16_t* dst = VT + ((size_t)((b * 4 + kvh) * 64 + d)) * SEQ + s;
#pragma unroll
                        for (int j = 0; j < 4; ++j) { dst[(size_t)j * SEQ] = f2bf(v0[j]); dst[(size_t)(j + 4) * SEQ] = f2bf(v1[j]); }
                    } else {
                        if (rot) {
                            f32x4 p0, p1;
#pragma unroll
                            for (int j = 0; j < 4; ++j) { p0[j] = __shfl_xor(v0[j], 16); p1[j] = __shfl_xor(v1[j], 16); }
                            if (fq < 2) {
                                const f32x4 c0v = rp_[m][0], c1v = rp_[m][1], s0v = rp_[m][2], s1v = rp_[m][3];
                                const float sg = (fq == 0) ? -1.f : 1.f;
                                v0 = v0 * c0v + (p0 * s0v) * sg; v1 = v1 * c1v + (p1 * s1v) * sg;
                            }
                        }
                        *(u32x4*)(P + (size_t)row * AIN + c0) = pack8(v0, v1);
                    }
                }
                asm volatile("" ::: "memory");
            }
        }
    }
};
struct EpiMemKV {
    static constexpr bool PERM = true, AFTER_DRAIN = false;
    bf16_t* KM; bf16_t* VMT;
    __device__ __forceinline__ void operator()(const f32x4 (&acc)[2][2][4][2], const pg8::Unit& u, int wr, int wc, int fr, int fq) const {
        asm volatile("" : "+v"(fr), "+v"(fq));
#pragma unroll
        for (int ai = 0; ai < 2; ++ai)
#pragma unroll
            for (int m = 0; m < 4; ++m) {
                const int row = u.pm * 256 + ai * 128 + wr * 64 + m * 16 + fr;
#pragma unroll
                for (int bj = 0; bj < 2; ++bj) {
                    const int c = u.pn * 256 + bj * 128 + wc * 32 + 8 * fq, l = c >> 10, j0 = c & 1023;
                    const f32x4 v0 = acc[ai][bj][m][0], v1 = acc[ai][bj][m][1];
                    if (j0 < 512) { *(u32x4*)(KM + (size_t)row * 1024 + l * 512 + j0) = pack8(v0, v1); }
                    else {
                        const int jj = j0 - 512, hm = jj >> 7, d = jj & 127, b = row >> 8, mm = row & 255;
                        bf16_t* dst = VMT + ((size_t)(((l * 4 + b) * 4 + hm) * 128 + d)) * 256 + mm;
#pragma unroll
                        for (int j = 0; j < 4; ++j) { dst[(size_t)j * 256] = f2bf(v0[j]); dst[(size_t)(j + 4) * 256] = f2bf(v1[j]); }
                    }
                }
                asm volatile("" ::: "memory");
            }
    }
};
__device__ __forceinline__ void unpack8(const u32x4 w, f32x4& a, f32x4& b2) {
    a[0] = __uint_as_float(w.x << 16); a[1] = __uint_as_float(w.x & 0xffff0000u); a[2] = __uint_as_float(w.y << 16); a[3] = __uint_as_float(w.y & 0xffff0000u);
    b2[0] = __uint_as_float(w.z << 16); b2[1] = __uint_as_float(w.z & 0xffff0000u); b2[2] = __uint_as_float(w.w << 16); b2[3] = __uint_as_float(w.w & 0xffff0000u);
}
template <bool RES_BF16>
struct EpiRes {
    static constexpr bool PERM = true, AFTER_DRAIN = false;
    const void* res; bf16_t* outb; float* ss; LAS float* part;
    __device__ __forceinline__ void operator()(const f32x4 (&acc)[2][2][4][2], const pg8::Unit& u, int wr, int wc, int fr, int fq) const {
        asm volatile("" : "+v"(fr), "+v"(fq));
#pragma unroll
        for (int ai = 0; ai < 2; ++ai) {
            f32x4 pre[4][2][2]; u32x4 prb[4][2];
#pragma unroll
            for (int m = 0; m < 4; ++m)
#pragma unroll
                for (int bj = 0; bj < 2; ++bj) {
                    const size_t off = (size_t)(u.pm * 256 + ai * 128 + wr * 64 + m * 16 + fr) * DM + u.pn * 256 + bj * 128 + wc * 32 + 8 * fq;
                    if (RES_BF16) prb[m][bj] = __builtin_nontemporal_load((const u32x4*)((const bf16_t*)res + off));
                    else { pre[m][bj][0] = __builtin_nontemporal_load((const f32x4*)((const float*)res + off)); pre[m][bj][1] = __builtin_nontemporal_load((const f32x4*)((const float*)res + off + 4)); }
                }
            asm volatile("" ::: "memory");
#pragma unroll
            for (int m = 0; m < 4; ++m) {
                const int row = u.pm * 256 + ai * 128 + wr * 64 + m * 16 + fr;
                float sq = 0.f;
#pragma unroll
                for (int bj = 0; bj < 2; ++bj) {
                    const size_t off = (size_t)row * DM + u.pn * 256 + bj * 128 + wc * 32 + 8 * fq;
                    f32x4 r0, r1;
                    if (RES_BF16) unpack8(prb[m][bj], r0, r1); else { r0 = pre[m][bj][0]; r1 = pre[m][bj][1]; }
                    const f32x4 o0 = acc[ai][bj][m][0] + r0, o1 = acc[ai][bj][m][1] + r1;
                    sq += (o0[0] * o0[0] + o0[1] * o0[1]) + (o0[2] * o0[2] + o0[3] * o0[3]) + (o1[0] * o1[0] + o1[1] * o1[1]) + (o1[2] * o1[2] + o1[3] * o1[3]);
                    *(u32x4*)(outb + off) = pack8(o0, o1);
                }
                sq += __shfl_xor(sq, 16); sq += __shfl_xor(sq, 32);
                if (fq == 0) part[(ai * 128 + wr * 64 + m * 16 + fr) * 4 + wc] = sq;
            }
            asm volatile("" ::: "memory");
        }
        asm volatile("s_waitcnt lgkmcnt(0)" ::: "memory"); __builtin_amdgcn_s_barrier(); asm volatile("" ::: "memory");
        { const int lane_ = fr + 16 * fq, row = (wr * 4 + wc) * 32 + (lane_ & 31);
          if (lane_ < 32) { const f32x4 p4 = *(const LAS f32x4*)(part + row * 4); atomicAdd(ss + u.pm * 256 + row, (p4[0] + p4[1]) + (p4[2] + p4[3])); } }
    }
};
struct EpiUp {
    static constexpr bool PERM = true, AFTER_DRAIN = false;
    bf16_t* H; const float* ss;
    __device__ __forceinline__ void operator()(const f32x4 (&acc)[2][2][4][2], const pg8::Unit& u, int wr, int wc, int fr, int fq) const {
        asm volatile("" : "+v"(fr), "+v"(fq));
        float rsv[2][4];
#pragma unroll
        for (int ai = 0; ai < 2; ++ai)
#pragma unroll
            for (int m = 0; m < 4; ++m) rsv[ai][m] = ss[u.pm * 256 + ai * 128 + wr * 64 + m * 16 + fr];
#pragma unroll
        for (int ai = 0; ai < 2; ++ai)
#pragma unroll
            for (int m = 0; m < 4; ++m) rsv[ai][m] = rsqrtf(rsv[ai][m] * (1.f / DM) + EPS);
#pragma unroll
        for (int ai = 0; ai < 2; ++ai)
#pragma unroll
            for (int m = 0; m < 4; ++m) {
                const int row = u.pm * 256 + ai * 128 + wr * 64 + m * 16 + fr;
                const float rs = rsv[ai][m];
#pragma unroll
                for (int bj = 0; bj < 2; ++bj) {
                    f32x4 v0 = acc[ai][bj][m][0] * rs, v1 = acc[ai][bj][m][1] * rs;
#pragma unroll
                    for (int j = 0; j < 4; ++j) { const float a = fmaxf(v0[j], 0.f), b = fmaxf(v1[j], 0.f); v0[j] = a * a; v1[j] = b * b; }
                    *(u32x4*)(H + (size_t)row * DFF + u.pn * 256 + bj * 128 + wc * 32 + 8 * fq) = pack8(v0, v1);
                }
                asm volatile("" ::: "memory");
            }
    }
};
struct EpiInL1 {
    static constexpr bool PERM = true, AFTER_DRAIN = false;
    bf16_t* PL; const float* ss;
    __device__ __forceinline__ void operator()(const f32x4 (&acc)[2][2][4][2], const pg8::Unit& u, int wr, int wc, int fr, int fq) const {
        asm volatile("" : "+v"(fr), "+v"(fq));
        float rsv[2][4];
#pragma unroll
        for (int ai = 0; ai < 2; ++ai)
#pragma unroll
            for (int m = 0; m < 4; ++m) rsv[ai][m] = ss[u.pm * 256 + ai * 128 + wr * 64 + m * 16 + fr];
#pragma unroll
        for (int ai = 0; ai < 2; ++ai)
#pragma unroll
            for (int m = 0; m < 4; ++m) rsv[ai][m] = rsqrtf(rsv[ai][m] * (1.f / DM) + EPS);
        const bool gate = (u.pn >= 4 && u.pn < 8);
#pragma unroll
        for (int ai = 0; ai < 2; ++ai)
#pragma unroll
            for (int m = 0; m < 4; ++m) {
                const int row = u.pm * 256 + ai * 128 + wr * 64 + m * 16 + fr;
                const float rs = rsv[ai][m];
#pragma unroll
                for (int bj = 0; bj < 2; ++bj) {
                    f32x4 v0 = acc[ai][bj][m][0] * rs, v1 = acc[ai][bj][m][1] * rs;
                    if (gate) {
#pragma unroll
                        for (int j = 0; j < 4; ++j) { v0[j] = gelu_tanh(v0[j]); v1[j] = gelu_tanh(v1[j]); }
                    }
                    *(u32x4*)(PL + (size_t)row * LIN + u.pn * 256 + bj * 128 + wc * 32 + 8 * fq) = pack8(v0, v1);
                }
                asm volatile("" ::: "memory");
            }
    }
};

struct RevRounds {
    pg8::StaticOrder so; int rounds;
    __device__ __forceinline__ void init(int M, int N, int G, int c) { so.init(M, N, G, c); rounds = (so.nwg + G - 1) / G; }
    __device__ __forceinline__ bool next(int i, pg8::Unit& u) const { return i < rounds && so.next(rounds - 1 - i, u); }
    __device__ __forceinline__ void a_ready(const pg8::Unit&) const {}
    __device__ __forceinline__ void done(const pg8::Unit&) const {}
};

constexpr int TP_STR = 65, TP_BYTES = 64 * TP_STR * 4;
__device__ __forceinline__ void transpose_tile64(const float* W, int ldw, int k0, int n0, bf16_t* dst, int ldd, const float* gk, int gate_g, LAS float* scr, int lane) {
    const int l16 = lane & 15, lr = lane >> 4;
    f32x4 v[16];
#pragma unroll
    for (int i = 0; i < 16; ++i) v[i] = __builtin_nontemporal_load((const f32x4*)(W + (size_t)(k0 + 4 * i + lr) * ldw + n0 + 4 * l16));
    if (gk) {
#pragma unroll
        for (int i = 0; i < 16; ++i) v[i] = v[i] * gk[k0 + 4 * i + lr];
    }
#pragma unroll
    for (int i = 0; i < 16; ++i) { LAS float* p = scr + (4 * i + lr) * TP_STR + 4 * l16; p[0] = v[i][0]; p[1] = v[i][1]; p[2] = v[i][2]; p[3] = v[i][3]; }
    asm volatile("s_waitcnt lgkmcnt(0)" ::: "memory");
    const int c = lane & 7;
#pragma unroll
    for (int j = 0; j < 8; ++j) { const int n = (lane >> 3) + 8 * j; const LAS float* s = scr + (8 * c) * TP_STR + n;
        u32x4 o; o.x = cvt_pk_bf16(s[0 * TP_STR], s[1 * TP_STR]); o.y = cvt_pk_bf16(s[2 * TP_STR], s[3 * TP_STR]); o.z = cvt_pk_bf16(s[4 * TP_STR], s[5 * TP_STR]); o.w = cvt_pk_bf16(s[6 * TP_STR], s[7 * TP_STR]);
        const int ng = n0 + n, row = (gate_g >= 0) ? ((ng >> 5) * 128 + gate_g * 32 + (ng & 31)) : ng;
        *(u32x4*)(dst + (size_t)row * ldd + k0 + 8 * c) = o; }
    asm volatile("s_waitcnt lgkmcnt(0)" ::: "memory");
}
__device__ __forceinline__ void transpose_matrix(const float* W, int K, int N, bf16_t* WT, const float* gk, LAS float* scr, int lane, int gw, int ngw) {
    const int nblk = N / 64, nitems = (K / 64) * nblk;
    for (int it = gw; it < nitems; it += ngw) { const int kb = it / nblk, nb = it % nblk; transpose_tile64(W, N, 64 * kb, 64 * nb, WT, K, gk, -1, scr, lane); }
}
__device__ __forceinline__ void rms_row_to_bf16(const float* xrow, const float* g, bf16_t* orow, int lane) {
    const f32x4* xr = (const f32x4*)xrow + lane; const f32x4* gr = (const f32x4*)g + lane;
    f32x4 v[4]; float s = 0.f;
#pragma unroll
    for (int j = 0; j < 4; ++j) { v[j] = xr[64 * j]; s += (v[j].x * v[j].x + v[j].y * v[j].y) + (v[j].z * v[j].z + v[j].w * v[j].w); }
    const float rs = rsqrtf(wave_sum(s) * (1.f / DM) + EPS);
    u32x2* o8 = (u32x2*)orow + lane;
#pragma unroll
    for (int j = 0; j < 4; ++j) { const f32x4 gg = gr[64 * j]; u32x2 w; w.x = cvt_pk_bf16(v[j].x * rs * gg.x, v[j].y * rs * gg.y); w.y = cvt_pk_bf16(v[j].z * rs * gg.z, v[j].w * rs * gg.w); o8[64 * j] = w; }
}

__device__ __forceinline__ void rms_rows4_to_bf16(const float* xrow, const float* g, bf16_t* orow, int lane) {
    f32x4 v[4][4]; float s[4];
#pragma unroll
    for (int i = 0; i < 4; ++i)
#pragma unroll
        for (int j = 0; j < 4; ++j) v[i][j] = __builtin_nontemporal_load((const f32x4*)(xrow + (size_t)i * DM) + lane + 64 * j);
#pragma unroll
    for (int i = 0; i < 4; ++i) { s[i] = 0.f;
#pragma unroll
        for (int j = 0; j < 4; ++j) s[i] += (v[i][j].x * v[i][j].x + v[i][j].y * v[i][j].y) + (v[i][j].z * v[i][j].z + v[i][j].w * v[i][j].w); }
#pragma unroll
    for (int o = 1; o < 64; o <<= 1) {
#pragma unroll
        for (int i = 0; i < 4; ++i) s[i] += __shfl_xor(s[i], o); }
    const f32x4* gr = (const f32x4*)g + lane;
#pragma unroll
    for (int i = 0; i < 4; ++i) { const float rs = rsqrtf(s[i] * (1.f / DM) + EPS); u32x2* o8 = (u32x2*)(orow + (size_t)i * DM) + lane;
#pragma unroll
        for (int j = 0; j < 4; ++j) { const f32x4 gg = gr[64 * j]; u32x2 w; w.x = cvt_pk_bf16(v[i][j].x * rs * gg.x, v[i][j].y * rs * gg.y); w.y = cvt_pk_bf16(v[i][j].z * rs * gg.z, v[i][j].w * rs * gg.w); o8[64 * j] = w; } }
}

__device__ __forceinline__ float half_max(float x) { auto rr = __builtin_amdgcn_permlane32_swap(__float_as_uint(x), __float_as_uint(x), false, false); return fmaxf(__uint_as_float(rr[0]), __uint_as_float(rr[1])); }
__device__ __forceinline__ float half_sum(float x) { auto rr = __builtin_amdgcn_permlane32_swap(__float_as_uint(x), __float_as_uint(x), false, false); return __uint_as_float(rr[0]) + __uint_as_float(rr[1]); }
__device__ __forceinline__ float swap32(float x, int hi) { auto rr = __builtin_amdgcn_permlane32_swap(__float_as_uint(x), __float_as_uint(x), false, false); return __uint_as_float(hi ? rr[0] : rr[1]); }
template <int D, int KSTRB, int VSTRB, bool WIN, int NQ>
__device__ __forceinline__ void attn_rows(const LAS unsigned char* Kl, const LAS unsigned char* Vl, const bf16_t* qrow, size_t qgstride, int kt_lo, int kt_hi, int q0, int qi,
                                          float sinkl2, float C1, bf16_t* orow0, int ldo, int r32, int hi) {
    constexpr int ND = D / 16, NG = D / 32, NC = (NQ == 1) ? 2 : 1;
    bf16x8 qf[NQ][ND];
#pragma unroll
    for (int n = 0; n < NQ; ++n)
#pragma unroll
        for (int d0 = 0; d0 < ND; ++d0) qf[n][d0] = __builtin_nontemporal_load((const bf16x8*)(qrow + n * qgstride + d0 * 16 + hi * 8));
    float m2[NQ], l[NQ]; f32x16 o[NQ][NG];
#pragma unroll
    for (int n = 0; n < NQ; ++n) {
        m2[n] = WIN ? sinkl2 : -1e30f; l[n] = 0.f;
#pragma unroll
        for (int g = 0; g < NG; ++g)
#pragma unroll
            for (int r = 0; r < 16; ++r) o[n][g][r] = 0.f;
    }
    for (int kt = kt_lo; kt < kt_hi; ++kt) {
        if (WIN) { if (kt < 4 && kt * 32 + 31 < q0) continue; if (kt >= 8 && (kt - 8) * 32 > q0 + 32 * NQ - 1) continue; }
        const LAS unsigned char* kp = Kl + (kt * 32 + r32) * KSTRB + hi * 16;
        const int cmsk = (kt >= 8) ? -1 : 0; int thr_t[NQ];
#pragma unroll
        for (int n = 0; n < NQ; ++n) { const int qn = qi + 32 * n - 4 * hi - kt * 32; thr_t[n] = (kt < 4) ? qn : ((kt >= 8) ? ~(qn + 256) : -1000); }
        bf16x8 kf[ND];
#pragma unroll
        for (int d0 = 0; d0 < ND; ++d0) kf[d0] = *(const LAS bf16x8*)(kp + d0 * 32);
        f32x16 st[NQ][NC];
        if (WIN && (kt < 4 || kt >= 8)) {
#pragma unroll
            for (int n = 0; n < NQ; ++n)
#pragma unroll
                for (int c = 0; c < NC; ++c)
#pragma unroll
                    for (int r = 0; r < 16; ++r) st[n][c][r] = (c == 0) ? (((crow(r, 0) ^ cmsk) >= thr_t[n]) ? 0.f : -1e30f) : 0.f;
        } else {
#pragma unroll
            for (int n = 0; n < NQ; ++n)
#pragma unroll
                for (int c = 0; c < NC; ++c)
#pragma unroll
                    for (int r = 0; r < 16; ++r) st[n][c][r] = 0.f;
        }
#pragma unroll
        for (int d0 = 0; d0 < ND; ++d0)
#pragma unroll
            for (int n = 0; n < NQ; ++n) st[n][d0 % NC] = __builtin_amdgcn_mfma_f32_32x32x16_bf16(kf[d0], qf[n][d0], st[n][d0 % NC], 0, 0, 0);
        bf16x8 pa[NQ][2];
#pragma unroll
        for (int n = 0; n < NQ; ++n) {
            float p[16]; float tmax = -1e30f;
#pragma unroll
            for (int r = 0; r < 16; ++r) {
                float s = st[n][0][r]; if (NC == 2) s += st[n][NC - 1][r];
                p[r] = s; tmax = fmaxf(tmax, s);
            }
            tmax = half_max(tmax) * C1;
            if (__any(tmax > m2[n] + 8.f)) {
                const float mn = fmaxf(m2[n], tmax), f = fast_exp2(m2[n] - mn);
                l[n] *= f; m2[n] = mn;
#pragma unroll
                for (int r = 0; r < 16; ++r) { const float fr_ = __shfl(f, crow(r, hi));
#pragma unroll
                    for (int g = 0; g < NG; ++g) o[n][g][r] *= fr_; }
            }
#pragma unroll
            for (int r = 0; r < 16; ++r) { p[r] = fast_exp2(p[r] * C1 - m2[n]); l[n] += p[r]; }
            u32x4 w0, w1; w0.x = cvt_pk_bf16(p[0], p[1]); w0.y = cvt_pk_bf16(p[2], p[3]); w0.z = cvt_pk_bf16(p[4], p[5]); w0.w = cvt_pk_bf16(p[6], p[7]);
            w1.x = cvt_pk_bf16(p[8], p[9]); w1.y = cvt_pk_bf16(p[10], p[11]); w1.z = cvt_pk_bf16(p[12], p[13]); w1.w = cvt_pk_bf16(p[14], p[15]);
            pa[n][0] = __builtin_bit_cast(bf16x8, w0); pa[n][1] = __builtin_bit_cast(bf16x8, w1);
        }
#pragma unroll
        for (int h2 = 0; h2 < 2; ++h2) {
            bf16x8 vb[NG];
#pragma unroll
            for (int g = 0; g < NG; ++g) {
                const LAS unsigned char* vp = Vl + (g * 32 + r32) * VSTRB + (kt * 32 + 16 * h2 + 4 * hi) * 2;
                const s16x4 lo = *(const LAS s16x4*)vp, hh = *(const LAS s16x4*)(vp + 16);
                vb[g] = (bf16x8){lo[0], lo[1], lo[2], lo[3], hh[0], hh[1], hh[2], hh[3]};
            }
#pragma unroll
            for (int g = 0; g < NG; ++g)
#pragma unroll
                for (int n = 0; n < NQ; ++n) o[n][g] = __builtin_amdgcn_mfma_f32_32x32x16_bf16(pa[n][h2], vb[g], o[n][g], 0, 0, 0);
        }
    }
#pragma unroll
    for (int n = 0; n < NQ; ++n) {
        float lt = half_sum(l[n]); if (WIN) lt += fast_exp2(sinkl2 - m2[n]);
        const float linv = 1.f / lt;
#pragma unroll
        for (int r = 0; r < 16; ++r) {
            const int q = crow(r, hi); const float li = __shfl(linv, q);
#pragma unroll
            for (int g = 0; g < NG; ++g) orow0[(size_t)(32 * n + q) * ldo + g * 32 + r32] = f2bf(o[n][g][r] * li);
        }
    }
}

constexpr int WK_STR = 144, WV_STR = 784, WV_OFF = 384 * WK_STR;
__device__ __forceinline__ void wattn_unit(LAS unsigned char* lds, const bf16_t* P, const bf16_t* VT, bf16_t* MIX, const float* sinks, int b, int nblk, int kvh, const int wave_s) {
    const int lane = opaque_lane(), wid = wave_s, tid = wid * 64 + lane, r32 = lane & 31, hi = lane >> 5;
    const int s0 = nblk * 128 - 128;
    {
        u32x4 kv_[6], vv_[6];
#pragma unroll
        for (int k = 0; k < 6; ++k) { const int i = tid + NTHREADS * k, row = i >> 3, ch = i & 7; int s = s0 + row; s = s < 0 ? 0 : (s > SEQ - 1 ? SEQ - 1 : s);
            kv_[k] = __builtin_nontemporal_load((const u32x4*)(P + ((size_t)(b * SEQ + s)) * AIN + 1024 + kvh * 64 + ch * 8)); }
#pragma unroll
        for (int k = 0; k < 6; ++k) { const int i = tid + NTHREADS * k, d = i / 48, ch = i % 48; int s = s0 + ch * 8; s = s < 0 ? 0 : (s > SEQ - 8 ? SEQ - 8 : s);
            vv_[k] = __builtin_nontemporal_load((const u32x4*)(VT + ((size_t)((b * 4 + kvh) * 64 + d)) * SEQ + s)); }
#pragma unroll
        for (int k = 0; k < 6; ++k) { const int i = tid + NTHREADS * k, row = i >> 3, ch = i & 7; *(LAS u32x4*)(lds + row * WK_STR + ch * 16) = kv_[k]; }
#pragma unroll
        for (int k = 0; k < 6; ++k) { const int i = tid + NTHREADS * k, d = i / 48, ch = i % 48; *(LAS u32x4*)(lds + WV_OFF + d * WV_STR + ch * 16) = vv_[k]; }
    }
    __syncthreads();
    const int hq = kvh * 4 + (wid >> 1);
    const float sinkl2 = sinks[hq] * LOG2E;
    const int kt_lo = (nblk == 0) ? 4 : 0, kt_hi = (nblk == SEQ / 128 - 1) ? 8 : 12;
    {
        const int q0 = (wid & 1) * 64, qi = q0 + r32;
        const size_t tok0 = (size_t)b * SEQ + nblk * 128 + q0;
        attn_rows<64, WK_STR, WV_STR, true, 2>(lds, lds + WV_OFF, P + (tok0 + r32) * AIN + hq * 64, (size_t)32 * AIN, kt_lo, kt_hi, q0, qi, sinkl2, 0.125f * LOG2E,
                                              MIX + tok0 * MIXW + hq * 64, MIXW, r32, hi);
    }
    __syncthreads();
}
constexpr int MK_STR = 272, MV_STR = 528, MV_OFF = 256 * MK_STR;
__device__ __forceinline__ void mattn_unit(LAS unsigned char* lds, const bf16_t* PQ, int ldq, int qcol, const bf16_t* KM, const bf16_t* VMT, bf16_t* MIX, int layer, int b, int hm, int qblk, const int wave_s) {
    const int lane = opaque_lane(), wid = wave_s, tid = wid * 64 + lane, r32 = lane & 31, hi = lane >> 5;
    {
        u32x4 kv_[8], vv_[8];
#pragma unroll
        for (int k = 0; k < 8; ++k) { const int i = tid + NTHREADS * k, row = i >> 4, ch = i & 15; kv_[k] = *(const u32x4*)(KM + ((size_t)(b * 256 + row)) * 1024 + layer * 512 + hm * 128 + ch * 8); }
#pragma unroll
        for (int k = 0; k < 8; ++k) { const int i = tid + NTHREADS * k, d = i >> 5, ch = i & 31; vv_[k] = *(const u32x4*)(VMT + ((size_t)(((layer * 4 + b) * 4 + hm) * 128 + d)) * 256 + ch * 8); }
#pragma unroll
        for (int k = 0; k < 8; ++k) { const int i = tid + NTHREADS * k, row = i >> 4, ch = i & 15; *(LAS u32x4*)(lds + row * MK_STR + ch * 16) = kv_[k]; }
#pragma unroll
        for (int k = 0; k < 8; ++k) { const int i = tid + NTHREADS * k, d = i >> 5, ch = i & 31; *(LAS u32x4*)(lds + MV_OFF + d * MV_STR + ch * 16) = vv_[k]; }
    }
    __syncthreads();
    for (int qg = 0; qg < 2; ++qg) {
        const size_t tok0 = (size_t)b * SEQ + qblk * 512 + wid * 64 + qg * 32;
        attn_rows<128, MK_STR, MV_STR, false, 1>(lds, lds + MV_OFF, PQ + (tok0 + r32) * ldq + qcol + hm * 128, 0, 0, 8, 0, 0, 0.f, 0.08838834764831845f * LOG2E,
                                                 MIX + tok0 * MIXW + 1024 + hm * 128, MIXW, r32, hi);
    }
    __syncthreads();
}

template <int DIR>
__device__ __forceinline__ void lru_tg(f32x16& a, f32x16& u, int hi, float& Pc, float& Xc) {
#pragma unroll
    for (int q = 0; q < 4; ++q) {
        const int r0 = q * 4;
        if (DIR == 0) { float c = a[r0], h = u[r0];
#pragma unroll
            for (int i = 1; i < 4; ++i) { h = a[r0 + i] * h + u[r0 + i]; c *= a[r0 + i]; a[r0 + i] = c; u[r0 + i] = h; } }
        else { float c = a[r0 + 3], h = u[r0 + 3];
#pragma unroll
            for (int i = 2; i >= 0; --i) { h = a[r0 + i] * h + u[r0 + i]; c *= a[r0 + i]; a[r0 + i] = c; u[r0 + i] = h; } }
    }
    const bool lead = (hi == DIR);
#pragma unroll
    for (int jj = 0; jj < 4; ++jj) {
        const int q = DIR ? 3 - jj : jj, rl = DIR ? q * 4 : q * 4 + 3;
        const float C = a[rl], H = u[rl];
        const float Pe = C * Pc, Xe = C * Xc + H;
        const float Pp = swap32(Pe, hi), Xp = swap32(Xe, hi);
        const float Pin = lead ? Pc : Pp, Xin = lead ? Xc : Xp;
        const float Pf = C * Pin, Xf = C * Xin + H;
        Pc = swap32(Pf, hi); Xc = swap32(Xf, hi);
#pragma unroll
        for (int i = 0; i < 4; ++i) { const int r = q * 4 + i; u[r] += a[r] * Xin; a[r] *= Pin; }
    }
}

struct LruP { const bf16_t* PL; const float* conv_w; const float* conv_b; const float* ba; const float* bx; const float* lam; const bf16_t* WG; bf16_t* CAF; bf16_t* CAB; bf16_t* MIX; float* SUM; };
constexpr int XC_STR = 272, HS_OFF = 128 * XC_STR;
constexpr int CW_OFF = HS_OFF + 65536;
__device__ __forceinline__ void lru_conv_load(const LruP& L, int uidx, int tid, bf16x8 (&xv)[7]) {
    const int blk = uidx & 7, c = (uidx >> 3) & 63, b = uidx >> 9, cbase = blk * 128 + (tid & 15) * 8, t0 = (tid >> 4) * 4;
#pragma unroll
    for (int i = 0; i < 7; ++i) { const int s = c * 128 + t0 + i - 1, sc = s < 0 ? 0 : (s > SEQ - 1 ? SEQ - 1 : s);
        xv[i] = __builtin_nontemporal_load((const bf16x8*)(L.PL + ((size_t)(b * SEQ + sc)) * LIN + cbase)); }
}
__device__ __forceinline__ void lru_conv_finish(LAS unsigned char* lds, int uidx, int tid, const bf16x8 (&xv)[7]) {
    const int c = (uidx >> 3) & 63, ch8 = tid & 15, t0 = (tid >> 4) * 4;
    const LAS float* cw = (const LAS float*)(lds + CW_OFF);
    float xf[7][8];
#pragma unroll
    for (int i = 0; i < 7; ++i) { const int s = c * 128 + t0 + i - 1; const float mk = (s >= 0 && s < SEQ) ? 1.f : 0.f;
#pragma unroll
        for (int j = 0; j < 8; ++j) xf[i][j] = bf2f((unsigned short)xv[i][j]) * mk; }
    float sum[4][8];
    { const f32x4 b0 = *(const LAS f32x4*)(cw + 512 + ch8 * 8), b1 = *(const LAS f32x4*)(cw + 512 + ch8 * 8 + 4);
#pragma unroll
      for (int k = 0; k < 4; ++k)
#pragma unroll
          for (int j = 0; j < 4; ++j) { sum[k][j] = b0[j]; sum[k][j + 4] = b1[j]; } }
#pragma unroll
    for (int tap = 0; tap < 4; ++tap) {
        const f32x4 w0 = *(const LAS f32x4*)(cw + tap * 128 + ch8 * 8), w1 = *(const LAS f32x4*)(cw + tap * 128 + ch8 * 8 + 4);
#pragma unroll
        for (int k = 0; k < 4; ++k)
#pragma unroll
            for (int j = 0; j < 4; ++j) { sum[k][j] += xf[k + tap][j] * w0[j]; sum[k][j + 4] += xf[k + tap][j + 4] * w1[j]; }
    }
#pragma unroll
    for (int k = 0; k < 4; ++k) { u32x4 o; o.x = cvt_pk_bf16(sum[k][0], sum[k][1]); o.y = cvt_pk_bf16(sum[k][2], sum[k][3]); o.z = cvt_pk_bf16(sum[k][4], sum[k][5]); o.w = cvt_pk_bf16(sum[k][6], sum[k][7]);
        *(LAS u32x4*)(lds + (t0 + k) * XC_STR + ch8 * 16) = o; }
}
__device__ __forceinline__ void lru_units(LAS unsigned char* lds, const LruP& L, int bx, int G, const int wave_s) {
    const int lane = opaque_lane(), wid = wave_s, tid = wid * 64 + lane, r32 = lane & 31, hi = lane >> 5;
    const int cg_ = wid & 3, dir = wid >> 2;
    int cur_blk = -1; float nba = 0.f, nbx = 0.f, sp16 = 0.f, spl = 0.f; bf16x8 bfr[2][8];
#pragma unroll
    for (int gi = 0; gi < 2; ++gi)
#pragma unroll
        for (int ks = 0; ks < 8; ++ks) bfr[gi][ks] = (bf16x8){0, 0, 0, 0, 0, 0, 0, 0};
    bf16x8 xv[7];
    int uidx = bx;
    if (uidx < 2048) lru_conv_load(L, uidx, tid, xv);
    for (; uidx < 2048; uidx += G) {
        const int blk = uidx & 7, c = (uidx >> 3) & 63, b = uidx >> 9, ch = blk * 128 + cg_ * 32 + r32;
        if (blk != cur_blk) {
            cur_blk = blk;
            if (tid < 160) { const int row = tid >> 5, col = (tid & 31) * 4;
                const f32x4 v = (row < 4) ? *(const f32x4*)(L.conv_w + row * 1024 + blk * 128 + col) : *(const f32x4*)(L.conv_b + blk * 128 + col);
                *(LAS f32x4*)(lds + CW_OFF + (row * 128 + col) * 4) = v; }
            nba = -L.ba[dir * 1024 + ch] * LOG2E; nbx = -L.bx[dir * 1024 + ch] * LOG2E;
            { const float xs = fast_exp2(-L.lam[dir * 1024 + ch] * LOG2E);
              const float ser = xs * (1.f - xs * (0.5f - xs * (0.33333334f - xs * 0.25f))), big = 0.6931471805599453f * __builtin_amdgcn_logf(1.f + xs);
              const float sp8 = -8.f * ((xs < 0.03f) ? ser : big); sp16 = 2.f * sp8; spl = sp8 * LOG2E; }
            const bf16_t* wrow = L.WG + ((size_t)(blk * 512 + cg_ * 128 + dir * 64 + r32)) * 128 + hi * 8;
#pragma unroll
            for (int ks = 0; ks < 8; ++ks) { bfr[0][ks] = *(const bf16x8*)(wrow + ks * 16); bfr[1][ks] = *(const bf16x8*)(wrow + 32 * 128 + ks * 16); }
            __syncthreads();
        }
        lru_conv_finish(lds, uidx, tid, xv);
        __syncthreads();
        if (uidx + G < 2048) lru_conv_load(L, uidx + G, tid, xv);
        {
            float Pc = 1.f, Xc = 0.f;
            const size_t tokbase = (size_t)b * SEQ + c * 128;
            bf16_t* ca = (dir == 0 ? L.CAF : L.CAB) + tokbase * DM + ch;
#pragma nounroll
            for (int it = 0; it < 4; ++it) {
                const int tg = dir ? 3 - it : it;
                f32x16 a, u;
#pragma unroll
                for (int r = 0; r < 16; ++r) { a[r] = 0.f; u[r] = 0.f; }
                const LAS unsigned char* xrow = lds + (tg * 32 + r32) * XC_STR + hi * 16;
                bf16x8 af[8];
#pragma unroll
                for (int ks = 0; ks < 8; ++ks) af[ks] = *(const LAS bf16x8*)(xrow + ks * 32);
#pragma unroll
                for (int ks = 0; ks < 8; ++ks) { a = __builtin_amdgcn_mfma_f32_32x32x16_bf16(af[ks], bfr[0][ks], a, 0, 0, 0); u = __builtin_amdgcn_mfma_f32_32x32x16_bf16(af[ks], bfr[1][ks], u, 0, 0, 0); }
                const LAS unsigned char* xcol = lds + (tg * 32 + 4 * hi) * XC_STR + (cg_ * 32 + r32) * 2;
                unsigned short xq[16];
#pragma unroll
                for (int r = 0; r < 16; ++r) xq[r] = *(const LAS unsigned short*)(xcol + crow(r, 0) * XC_STR);
#pragma unroll
                for (int r = 0; r < 16; ++r) {
                    const float xcv = bf2f(xq[r]);
                    const float rr = fast_rcp(1.f + fast_exp2(a[r] * (-LOG2E) + nba)), ii = fast_rcp(1.f + fast_exp2(u[r] * (-LOG2E) + nbx));
                    const float t2 = sp16 * rr;
                    const float ser = -t2 * (1.f + t2 * (0.5f + t2 * (0.16666667f + t2 * 0.041666668f)));
                    const float av = fast_exp2(spl * rr);
                    const float m1 = (t2 > -0.0625f) ? ser : (1.f - av * av);
                    a[r] = av;
                    u[r] = __builtin_amdgcn_sqrtf(m1) * ii * xcv;
                }
                if (dir == 0) lru_tg<0>(a, u, hi, Pc, Xc); else lru_tg<1>(a, u, hi, Pc, Xc);
                bf16_t* cat = ca + (size_t)(tg * 32 + 4 * hi) * DM;
                LAS unsigned short* hst = (LAS unsigned short*)(lds + HS_OFF + dir * 32768) + (tg * 32 + 4 * hi) * 128 + cg_ * 32 + r32;
#pragma unroll
                for (int r = 0; r < 16; r += 2) {
                    const unsigned pa_ = cvt_pk_bf16(a[r], a[r + 1]), pu_ = cvt_pk_bf16(u[r], u[r + 1]);
                    cat[(size_t)crow(r, 0) * DM] = (unsigned short)pa_; cat[(size_t)crow(r + 1, 0) * DM] = (unsigned short)(pa_ >> 16);
                    hst[crow(r, 0) * 128] = (unsigned short)pu_; hst[crow(r + 1, 0) * 128] = (unsigned short)(pu_ >> 16);
                }
            }
            if (hi == dir) { float* sp = L.SUM + ((size_t)(dir * 2) * 256 + (b * 64 + c)) * 1024 + ch; sp[0] = Pc; sp[(size_t)256 * 1024] = Xc; }
        }
        __syncthreads();
        {
            const size_t tokbase = (size_t)b * SEQ + c * 128;
#pragma unroll
            for (int k = 0; k < 4; ++k) {
                const int i = tid + NTHREADS * k, t = i >> 4, c8 = i & 15;
                const bf16x8 hf = *(const LAS bf16x8*)(lds + HS_OFF + (t * 128 + c8 * 8) * 2), hb = *(const LAS bf16x8*)(lds + HS_OFF + 32768 + (t * 128 + c8 * 8) * 2);
                float y[8];
#pragma unroll
                for (int j = 0; j < 8; ++j) y[j] = bf2f((unsigned short)hf[j]) + bf2f((unsigned short)hb[j]);
                u32x4 o; o.x = cvt_pk_bf16(y[0], y[1]); o.y = cvt_pk_bf16(y[2], y[3]); o.z = cvt_pk_bf16(y[4], y[5]); o.w = cvt_pk_bf16(y[6], y[7]);
                *(u32x4*)(L.MIX + (tokbase + t) * MIXW + blk * 128 + c8 * 8) = o;
            }
        }
        __syncthreads();
    }
}
__device__ __forceinline__ void lru_fix_unit(LAS unsigned char* lds, const float* SUM, const bf16_t* CAF, const bf16_t* CAB, const bf16_t* PL, bf16_t* MIX, int b, int c, const int wave_s) {
    const int tid = wave_s * 64 + opaque_lane();
    LAS float* car = (LAS float*)lds;
    {
        const int dir = tid >> 8, ch = (tid & 255) * 4;
        const float* SA = SUM + ((size_t)(dir * 2) * 256 + b * 64) * 1024 + ch; const float* SH = SA + (size_t)256 * 1024;
        f32x4 X = (f32x4){0.f, 0.f, 0.f, 0.f};
        const int n = dir ? 63 - c : c, first = dir ? 63 : 0, step = dir ? -1 : 1;
        for (int i0 = 0; i0 < n; i0 += 8) {
            f32x4 A[8], H[8];
#pragma unroll
            for (int j = 0; j < 8; ++j) { const int i = (i0 + j < n) ? i0 + j : n - 1, cc = first + step * i; A[j] = *(const f32x4*)(SA + (size_t)cc * 1024); H[j] = *(const f32x4*)(SH + (size_t)cc * 1024); }
#pragma unroll
            for (int j = 0; j < 8; ++j) if (i0 + j < n) X = A[j] * X + H[j];
        }
        *(LAS f32x4*)(car + dir * 1024 + ch) = X;
    }
    __syncthreads();
    const int ch8 = (tid & 127) * 8;
    float cf[8], cb[8];
#pragma unroll
    for (int j = 0; j < 8; ++j) { cf[j] = car[ch8 + j]; cb[j] = car[1024 + ch8 + j]; }
    for (int k0 = 0; k0 < 32; k0 += 4) {
        bf16x8 hs[4], af[4], ab[4], gt[4];
#pragma unroll
        for (int kk = 0; kk < 4; ++kk) {
            const size_t tok = (size_t)b * SEQ + c * 128 + (tid >> 7) + 4 * (k0 + kk);
            hs[kk] = __builtin_nontemporal_load((const bf16x8*)(MIX + tok * MIXW + ch8)); af[kk] = __builtin_nontemporal_load((const bf16x8*)(CAF + tok * DM + ch8)); ab[kk] = __builtin_nontemporal_load((const bf16x8*)(CAB + tok * DM + ch8)); gt[kk] = __builtin_nontemporal_load((const bf16x8*)(PL + tok * LIN + 1024 + ch8));
        }
#pragma unroll
        for (int kk = 0; kk < 4; ++kk) {
            const size_t tok = (size_t)b * SEQ + c * 128 + (tid >> 7) + 4 * (k0 + kk);
            float y[8];
#pragma unroll
            for (int j = 0; j < 8; ++j) y[j] = (bf2f((unsigned short)hs[kk][j]) + bf2f((unsigned short)af[kk][j]) * cf[j] + bf2f((unsigned short)ab[kk][j]) * cb[j]) * bf2f((unsigned short)gt[kk][j]);
            u32x4 o; o.x = cvt_pk_bf16(y[0], y[1]); o.y = cvt_pk_bf16(y[2], y[3]); o.z = cvt_pk_bf16(y[4], y[5]); o.w = cvt_pk_bf16(y[6], y[7]);
            *(u32x4*)(MIX + tok * MIXW + ch8) = o;
        }
    }
    __syncthreads();
}

#define RLX_AGENT __ATOMIC_RELAXED, __HIP_MEMORY_SCOPE_AGENT
#define XB_TMO      128
#define XB_XCNT(j)  (256  + 64 * (j))
#define XB_XSUB(j)  (1280 + 64 * (j))
#define XB_XGEN(j)  (2304 + 64 * (j))
#define XB_TOP      3328
#define XB_TOPGEN   3392
#define XCD_BAR_WORDS 3456
#define XB_SPIN_CAP (1u << 18)

__device__ __forceinline__ unsigned xb_ld(unsigned* p)              { return __hip_atomic_load(p, __ATOMIC_RELAXED, __HIP_MEMORY_SCOPE_AGENT); }
__device__ __forceinline__ unsigned xb_add(unsigned* p, unsigned v) { return __hip_atomic_fetch_add(p, v, __ATOMIC_RELAXED, __HIP_MEMORY_SCOPE_AGENT); }
__device__ __forceinline__ unsigned xb_xcc_id() { return (unsigned)__builtin_amdgcn_s_getreg((3 << 11) | 20) & 0xFu; }
#define XB_SPIN(cond, bar) do { unsigned _sp = 0; while (cond) { __builtin_amdgcn_s_sleep(1); \
    if ((++_sp & 255u) == 0u) { if (xb_ld(&(bar)[XB_TMO])) break; if (_sp > XB_SPIN_CAP) { atomicAdd(&(bar)[XB_TMO], 1u); break; } } } } while (0)

struct XcdBarrier {
    unsigned* bar; unsigned x;
    volatile LAS unsigned* st;
};

__device__ __forceinline__ XcdBarrier xcd_barrier_post(unsigned* bar, volatile LAS unsigned* st) {
    XcdBarrier b; b.bar = bar; b.x = xb_xcc_id(); b.st = st;
    if (threadIdx.x == 0) (void)xb_add(&bar[XB_XCNT(b.x)], 1u);
    return b;
}
__device__ __forceinline__ void xcd_barrier_complete(unsigned* bar, unsigned x, unsigned& nloc, unsigned& nx) {
    const unsigned G = gridDim.x * gridDim.y * gridDim.z;
    unsigned sum, cnt, mine, sp = 0u;
    for (;;) {
        sum = 0u; cnt = 0u; mine = 0u;
#pragma unroll
        for (unsigned j = 0; j < 16; ++j) { const unsigned c = xb_ld(&bar[XB_XCNT(j)]); sum += c; cnt += (c > 0u) ? 1u : 0u; mine = (j == x) ? c : mine; }
        if (sum == G) break;
        __builtin_amdgcn_s_sleep(1);
        if ((++sp & 255u) == 0u) { if (xb_ld(&bar[XB_TMO])) break; if (sp > XB_SPIN_CAP) { atomicAdd(&bar[XB_TMO], 1u); break; } }
    }
    nloc = mine > 0u ? mine : 1u; nx = cnt > 0u ? cnt : 1u;
}

__device__ __forceinline__ void xcd_barrier(const XcdBarrier& b) {
    asm volatile("s_waitcnt vmcnt(0)" ::: "memory");
    __syncthreads();
    if (threadIdx.x == 0) {
        unsigned* bar = b.bar;
        __builtin_amdgcn_s_waitcnt(0);
        unsigned nloc = b.st[0], nx = b.st[1];
        if (nloc == 0u) { xcd_barrier_complete(bar, b.x, nloc, nx); b.st[0] = nloc; b.st[1] = nx; }
        const unsigned old = xb_add(&bar[XB_XSUB(b.x)], 1u);
        const unsigned gen = old / nloc;
        if (old + 1u == (gen + 1u) * nloc) {
            __builtin_amdgcn_fence(__ATOMIC_RELEASE, "agent");
            asm volatile("s_waitcnt vmcnt(0)" ::: "memory");
            const unsigned og = xb_add(&bar[XB_TOP], 1u);
            const unsigned tg = og / nx;
            if (og + 1u == (tg + 1u) * nx) xb_add(&bar[XB_TOPGEN], 1u);
            else XB_SPIN(xb_ld(&bar[XB_TOPGEN]) == tg, bar);
            __builtin_amdgcn_fence(__ATOMIC_ACQUIRE, "agent");
            xb_add(&bar[XB_XGEN(b.x)], 1u);
            asm volatile("s_waitcnt vmcnt(0)" ::: "memory");
        } else {
            XB_SPIN(xb_ld(&bar[XB_XGEN(b.x)]) == gen, bar);
            __builtin_amdgcn_fence(__ATOMIC_ACQUIRE, "agent");
            asm volatile("s_waitcnt vmcnt(0)" ::: "memory");
        }
    }
    __syncthreads();
}

struct Args { const void* in[21]; float* out; unsigned char* ws; int ph_lo, ph_hi; };
constexpr int N_PHASES = 13;
#ifndef DUP_PHASE
#define DUP_PHASE (-1)
#endif

#define REPS(k) for (int rep_ = 0; rep_ < (((k) == DUP_PHASE) ? 2 : 1); ++rep_)

__global__ void __launch_bounds__(NTHREADS, 2) fwd_kernel(Args args) {
    extern __shared__ __attribute__((aligned(16))) unsigned char lds_raw[];
    LAS unsigned char* lds = (LAS unsigned char*)lds_raw;
    cg::grid_group grid = cg::this_grid();
    const int wave = __builtin_amdgcn_readfirstlane(threadIdx.x >> 6);
    const int G = gridDim.x, bx = blockIdx.x;
    const int gw = bx * 8 + wave, ngw = G * 8;
    const int lo = args.ph_lo, hi_ = args.ph_hi;
#define IN(k) (lo <= (k) && (k) < hi_)
#define SEAM(k) do { if (IN(k) && IN((k) + 1)) xcd_barrier(bar); } while (0)
    const float* x_in = (const float*)args.in[0]; const float* mem = (const float*)args.in[1]; const int* positions = (const int*)args.in[2];
    const float* mix_norm = (const float*)args.in[3]; const float* mlp_norm = (const float*)args.in[4]; const float* mem_norm = (const float*)args.in[5]; const float* final_norm = (const float*)args.in[6];
    const float* w_mem_kv = (const float*)args.in[7]; const float* w_out = (const float*)args.in[8]; const float* w_up = (const float*)args.in[9]; const float* w_down = (const float*)args.in[10];
    const float* attn_w_in = (const float*)args.in[11]; const float* attn_sinks = (const float*)args.in[12]; const float* lru_w_in = (const float*)args.in[13];
    const float* lru_conv_w = (const float*)args.in[14]; const float* lru_conv_b = (const float*)args.in[15]; const float* lru_wa = (const float*)args.in[16]; const float* lru_ba = (const float*)args.in[17];
    const float* lru_wx = (const float*)args.in[18]; const float* lru_bx = (const float*)args.in[19]; const float* lru_lambda = (const float*)args.in[20];
    unsigned char* ws = args.ws; float* X = args.out;
    unsigned* barw = (unsigned*)(ws + WS_BAR);
    volatile LAS unsigned* bst = (volatile LAS unsigned*)(lds + LDS_BYTES - 64);
    if (threadIdx.x == 0) { bst[0] = 0u; bst[1] = 0u; }
    __syncthreads();
    XcdBarrier bar; bar.bar = barw; bar.x = 0; bar.st = bst;
    if (args.ph_lo < 0) grid.sync();
    if (args.ph_hi - args.ph_lo > 1) bar = xcd_barrier_post(barw, bst);
    float* SS = (float*)(ws + WS_SS); float* ROPE = (float*)(ws + WS_ROPE); float* SUM = (float*)(ws + WS_SUM);
    bf16_t* KM = (bf16_t*)(ws + WS_KM); bf16_t* VMT = (bf16_t*)(ws + WS_VMT); bf16_t* MEMN = (bf16_t*)(ws + WS_MEMN);
    bf16_t* W_AIN = (bf16_t*)(ws + WS_W_AIN); bf16_t* W_LIN = (bf16_t*)(ws + WS_W_LIN); bf16_t* W_MKV = (bf16_t*)(ws + WS_W_MKV); bf16_t* W_GATE = (bf16_t*)(ws + WS_W_GATE);
    bf16_t* VT = (bf16_t*)(ws + WS_VT); bf16_t* XB = (bf16_t*)(ws + WS_XB); bf16_t* CAB = (bf16_t*)(ws + WS_CAB); bf16_t* PB = (bf16_t*)(ws + WS_P); bf16_t* MIX = (bf16_t*)(ws + WS_MIX); bf16_t* HB = (bf16_t*)(ws + WS_H);

    if (IN(0)) REPS(0) {
        const int lane = opaque_lane(), tid = wave * 64 + lane;
        for (int i = bx * NTHREADS + tid; i < 4 * T; i += G * NTHREADS) SS[i] = 0.f;
        for (int i = bx * NTHREADS + tid; i < T * 8; i += G * NTHREADS) {
            const int tok = i >> 3, f = i & 7;
            const float invf = (f == 0) ? 1.0f : (f == 1) ? 0.1939227432012558f : (f == 2) ? 0.03760603070259094f : (f == 3) ? 0.007292664609849453f : (f == 4) ? 0.0014142135623842478f
                             : (f == 5) ? 0.00027424818836152554f : (f == 6) ? 5.3182957344688475e-05f : 1.0313385246263351e-05f;
            const float ang = (float)positions[tok] * invf; float sn, cs; sincosf(ang, &sn, &cs);
            ROPE[(size_t)tok * 16 + f] = cs; ROPE[(size_t)tok * 16 + 8 + f] = sn;
        }
        LAS float* scr = (LAS float*)(lds + wave * TP_BYTES);
        {
            constexpr int I_AIN = (DM / 64) * (AIN / 64), I_LIN = (DM / 64) * (LIN / 64), I_OUT = (MIXW / 64) * (DM / 64), I_UP = (DM / 64) * (DFF / 64), I_DN = (DFF / 64) * (DM / 64), I_MKV = (DM / 64) * (1024 / 64), I_GATE = 128;
            constexpr int I_TOTAL = I_AIN + I_LIN + 2 * (I_OUT + I_UP + I_DN + I_MKV) + I_GATE;
            for (int it = gw; it < I_TOTAL; it += ngw) {
                int r = it;
                if (r < I_AIN) { transpose_tile64(attn_w_in, AIN, 64 * (r / (AIN / 64)), 64 * (r % (AIN / 64)), W_AIN, DM, nullptr, -1, scr, lane); continue; } r -= I_AIN;
                if (r < I_LIN) { transpose_tile64(lru_w_in, LIN, 64 * (r / (LIN / 64)), 64 * (r % (LIN / 64)), W_LIN, DM, mix_norm + DM, -1, scr, lane); continue; } r -= I_LIN;
                bool done = false;
#pragma unroll
                for (int l = 0; l < 2; ++l) {
                    if (done) break;
                    if (r < I_OUT) { transpose_tile64(w_out + (size_t)l * MIXW * DM, DM, 64 * (r / (DM / 64)), 64 * (r % (DM / 64)), (bf16_t*)(ws + (l ? WS_W_OUT1 : WS_W_OUT0)), MIXW, nullptr, -1, scr, lane); done = true; break; } r -= I_OUT;
                    if (r < I_UP) { transpose_tile64(w_up + (size_t)l * DM * DFF, DFF, 64 * (r / (DFF / 64)), 64 * (r % (DFF / 64)), (bf16_t*)(ws + (l ? WS_W_UP1 : WS_W_UP0)), DM, mlp_norm + l * DM, -1, scr, lane); done = true; break; } r -= I_UP;
                    if (r < I_DN) { transpose_tile64(w_down + (size_t)l * DFF * DM, DM, 64 * (r / (DM / 64)), 64 * (r % (DM / 64)), (bf16_t*)(ws + (l ? WS_W_DN1 : WS_W_DN0)), DFF, nullptr, -1, scr, lane); done = true; break; } r -= I_DN;
                    if (r < I_MKV) { transpose_tile64(w_mem_kv + (size_t)l * DM * 1024, 1024, 64 * (r / 16), 64 * (r % 16), W_MKV + (size_t)l * 1024 * DM, DM, nullptr, -1, scr, lane); done = true; break; } r -= I_MKV;
                }
                if (done) continue;
                {
                    const int n = r >> 4, g = (r >> 2) & 3, kb = (r >> 1) & 1, nb = r & 1;
                    const float* W = ((g & 1) ? lru_wx : lru_wa) + ((size_t)((g >> 1) * 8 + n)) * 128 * 128;
                    transpose_tile64(W, 128, 64 * kb, 64 * nb, W_GATE + (size_t)n * 512 * 128, 128, nullptr, g, scr, lane);
                }
            }
        }
        for (int m = gw; m < 1024; m += ngw) rms_row_to_bf16(mem + (size_t)m * DM, mem_norm, MEMN + (size_t)m * DM, lane);
        for (int m = gw * 4; m < T; m += ngw * 4) rms_rows4_to_bf16(x_in + (size_t)m * DM, mix_norm, XB + (size_t)m * DM, lane);
    }
    SEAM(0);
#pragma nounroll
    for (int layer = 0; layer < 2; ++layer) {
        const int pb = layer ? 6 : 1;
        if (IN(pb)) REPS(pb) {
            if (layer == 0) {
                { pg8::Gemm g{XB, W_AIN, T, AIN, DM}; pg8::StaticOrder S; S.init(T, AIN, G, bx); EpiInL0 E{PB, VT, ROPE};

#ifndef NO_EpiInL0
pg8::gemm_phase<EpiInL0, pg8::StaticOrder, true, true>(lds, g, S, E, wave);
#endif
 }
                { pg8::Gemm g{MEMN, W_MKV, 1024, 2048, DM}; pg8::StaticOrder S; S.init(1024, 2048, G, bx); EpiMemKV E{KM, VMT};

#ifndef NO_EpiMemKV
pg8::gemm_phase<EpiMemKV, pg8::StaticOrder, true, true>(lds, g, S, E, wave);
#endif
 }
            } else {
                pg8::Gemm g{XB, W_LIN, T, LIN, DM}; pg8::StaticOrder S; S.init(T, LIN, G, bx); EpiInL1 E{PB, SS + 1 * T};

#ifndef NO_EpiInL1
pg8::gemm_phase<EpiInL1, pg8::StaticOrder, true, true>(lds, g, S, E, wave);
#endif

            }
        }
        SEAM(pb);
        if (IN(pb + 1)) REPS(pb + 1) {
            if (layer == 0) {
                for (int uidx = bx; uidx < 1024 + 256; uidx += G) {
                    if (uidx < 1024) { const int kvh = uidx & 3, nblk = (uidx >> 2) & 63, b = uidx >> 8;
#ifndef NO_WATTN
 wattn_unit(lds, PB, VT, MIX, attn_sinks, b, nblk, kvh, wave);
#endif
 }
                    else { const int v = uidx - 1024, hm = v & 3, qblk = (v >> 2) & 15, b = v >> 6;
#ifndef NO_MATTN
 mattn_unit(lds, PB, AIN, 1536, KM, VMT, MIX, 0, b, hm, qblk, wave);
#endif
 }
                }
            } else {
                LruP L{PB, lru_conv_w, lru_conv_b, lru_ba, lru_bx, lru_lambda, W_GATE, (bf16_t*)X, CAB, MIX, SUM};
                lru_units(lds, L, bx, G, wave);
                for (int v = bx; v < 256; v += G) { const int hm = v & 3, qblk = (v >> 2) & 15, b = v >> 6; mattn_unit(lds, PB, LIN, 2048, KM, VMT, MIX, 1, b, hm, qblk, wave); }
            }
        }
        SEAM(pb + 1);
        if (layer == 1) {
            if (IN(8)) { for (int uidx = bx; uidx < 256; uidx += G) lru_fix_unit(lds, SUM, (const bf16_t*)X, CAB, PB, MIX, uidx >> 6, uidx & 63, wave); }
            SEAM(8);
        }
        const int po = layer ? 9 : 3;
        if (IN(po)) {
            pg8::Gemm g{MIX, (const bf16_t*)(ws + (layer ? WS_W_OUT1 : WS_W_OUT0)), T, DM, MIXW}; pg8::StaticOrder S; S.init(T, DM, G, bx);
            if (layer == 0) { EpiRes<false> E{x_in, XB, SS + 0 * T, (LAS float*)(lds + pg8::STAGE_BYTES)}; pg8::gemm_phase<EpiRes<false>, pg8::StaticOrder, true, true>(lds, g, S, E, wave); }
            else { EpiRes<true> E{XB, XB, SS + 2 * T, (LAS float*)(lds + pg8::STAGE_BYTES)}; pg8::gemm_phase<EpiRes<true>, pg8::StaticOrder, true, true>(lds, g, S, E, wave); }
        }
        SEAM(po);
        if (IN(po + 1)) REPS(po + 1) {
            pg8::Gemm g{XB, (const bf16_t*)(ws + (layer ? WS_W_UP1 : WS_W_UP0)), T, DFF, DM}; pg8::StaticOrder S; S.init(T, DFF, G, bx);
            EpiUp E{HB, SS + (layer ? 2 : 0) * T};

#ifndef NO_EpiUp
pg8::gemm_phase<EpiUp, pg8::StaticOrder, true, true>(lds, g, S, E, wave);
#endif

        }
        SEAM(po + 1);
        if (IN(po + 2)) {
            pg8::Gemm g{HB, (const bf16_t*)(ws + (layer ? WS_W_DN1 : WS_W_DN0)), T, DM, DFF}; RevRounds S; S.init(T, DM, G, bx);
            EpiRes<true> E{XB, XB, SS + (layer ? 3 : 1) * T, (LAS float*)(lds + pg8::STAGE_BYTES)};
            pg8::gemm_phase<EpiRes<true>, RevRounds, true, true>(lds, g, S, E, wave);
        }
        SEAM(po + 2);
    }
    if (IN(12)) {
        const int lane = opaque_lane();
        const float* ss = SS + 3 * T;
        f32x4 gg[2][2];
#pragma unroll
        for (int j = 0; j < 2; ++j) { gg[j][0] = *(const f32x4*)(final_norm + (lane + 64 * j) * 8); gg[j][1] = *(const f32x4*)(final_norm + (lane + 64 * j) * 8 + 4); }
        for (int m0 = gw * 4; m0 < T; m0 += ngw * 4) {
            u32x4 w[4][2]; float rs[4];
#pragma unroll
            for (int i = 0; i < 4; ++i) { rs[i] = rsqrtf(ss[m0 + i] * (1.f / DM) + EPS);
#pragma unroll
                for (int j = 0; j < 2; ++j) w[i][j] = __builtin_nontemporal_load((const u32x4*)(XB + (size_t)(m0 + i) * DM + (lane + 64 * j) * 8)); }
#pragma unroll
            for (int i = 0; i < 4; ++i)
#pragma unroll
                for (int j = 0; j < 2; ++j) { f32x4 a0, a1; unpack8(w[i][j], a0, a1); float* op = X + (size_t)(m0 + i) * DM + (lane + 64 * j) * 8;
                    __builtin_nontemporal_store(a0 * rs[i] * gg[j][0], (f32x4*)op); __builtin_nontemporal_store(a1 * rs[i] * gg[j][1], (f32x4*)(op + 4)); }
        }
    }
#undef IN
#undef SEAM
}

#ifndef MK_N_LAUNCHES
#define MK_N_LAUNCHES 1
#endif
extern "C" void kernel_launch(void* const* d_in, const int* in_sizes, int n_in, void* d_out, int out_size, void* d_ws, size_t ws_size, hipStream_t stream) {
    static int grid = 0;
    if (grid == 0) {
        if (n_in != 21 || in_sizes[0] != T * DM || out_size != T * DM || ws_size < WS_END) {
            fprintf(stderr, "kernel_launch: unexpected problem: n_in %d in0 %d out %d ws %zu (need %zu)\n", n_in, n_in > 0 ? in_sizes[0] : -1, out_size, ws_size, (size_t)WS_END); grid = -1; return; }
        int dev = 0, cus = 0, per_cu = 0;
        if (hipGetDevice(&dev) != hipSuccess || hipDeviceGetAttribute(&cus, hipDeviceAttributeMultiprocessorCount, dev) != hipSuccess) { fprintf(stderr, "kernel_launch: device query failed\n"); grid = -1; return; }
        if (hipFuncSetAttribute((const void*)fwd_kernel, hipFuncAttributeMaxDynamicSharedMemorySize, LDS_BYTES) != hipSuccess) { fprintf(stderr, "kernel_launch: hipFuncSetAttribute failed\n"); grid = -1; return; }
        if (hipOccupancyMaxActiveBlocksPerMultiprocessor(&per_cu, (const void*)fwd_kernel, NTHREADS, LDS_BYTES) != hipSuccess || per_cu < 1) { fprintf(stderr, "kernel_launch: occupancy query gave %d\n", per_cu); per_cu = 1; }
        (void)hipGetLastError();
        grid = cus;
        fprintf(stderr, "kernel_launch: grid %d (cus %d, per_cu %d)\n", grid, cus, per_cu);
    }
    if (grid < 0) return;
    Args a{};
    for (int i = 0; i < 21; ++i) a.in[i] = d_in[i];
    a.out = (float*)d_out; a.ws = (unsigned char*)d_ws;
#if MK_N_LAUNCHES == 1
    a.ph_lo = 0; a.ph_hi = N_PHASES;
    if (hipMemsetAsync((char*)d_ws + WS_BAR, 0, XCD_BAR_WORDS * 4, stream) != hipSuccess) { fprintf(stderr, "kernel_launch: memset of the barrier words failed\n"); return; }
    void* kargs[] = {&a};
    hipError_t e = hipLaunchCooperativeKernel((const void*)fwd_kernel, dim3(grid), dim3(NTHREADS), kargs, LDS_BYTES, stream);
    if (e != hipSuccess) fprintf(stderr, "kernel_launch: cooperative launch failed: %s (grid %d)\n", hipGetErrorString(e), grid);
#else
    for (int p = 0; p < N_PHASES; ++p) {
        a.ph_lo = p; a.ph_hi = p + 1;
        hipLaunchKernelGGL(fwd_kernel, dim3(grid), dim3(NTHREADS), LDS_BYTES, stream, a);
    }
#endif
}
```

```cpp
#include <hip/hip_runtime.h>
#include <hip/hip_cooperative_groups.h>
#include <cstdio>
#include <cstdint>
namespace cg = cooperative_groups;
namespace pg8 {
#define PG8_LAS __attribute__((address_space(3)))
typedef unsigned short bf16_t;
typedef short bf16x8 __attribute__((ext_vector_type(8)));
typedef float f32x4 __attribute__((ext_vector_type(4)));
typedef unsigned u32x4 __attribute__((ext_vector_type(4)));
constexpr int BM = 256, BK = 64, HALF = 128, HTB = HALF * BK * 2  , STAGE_BYTES = 8 * HTB, NXCD = 8, WGM = 8;

__host__ __device__ __forceinline__ int lds_byte(int r, int c) { const int st = (r >> 4) * 2 + (c >> 5), rr = r & 15, cc = c & 31, ob = rr * 64 + cc * 2; return st * 1024 + (ob ^ (((ob >> 9) & 1) << 5)); }
__host__ __device__ __forceinline__ void stage_rc(int b, int& R, int& C) { const int st = b / 1024, sb = b % 1024, swz = sb ^ (((sb >> 9) & 1) << 5); R = (st >> 1) * 16 + swz / 64; C = (st & 1) * 32 + (swz % 64) / 2; }
__host__ __device__ __forceinline__ int perm32(int rho) { const int n = rho >> 4, i = rho & 15; return 8 * (i >> 2) + 4 * n + (i & 3); }

struct Unit { int pm, pn; };
struct Gemm { const bf16_t* A; const bf16_t* Bt; int M, N, K; };

struct StaticOrder {
    int nM, nN, nwg, G, c;
    __host__ __device__ void init(int M, int N, int G_, int c_) { nM = M / BM; nN = N / BM; nwg = nM * nN; G = G_; c = c_; }
    __host__ __device__ bool next(int i, Unit& u) const {
        const long L = (long)i * G + c; if (L >= nwg) return false;
        int wgid = (int)L; { const int q = nwg / NXCD, r = nwg % NXCD, xcd = wgid % NXCD, off = wgid / NXCD; wgid = (xcd < r ? xcd * (q + 1) : r * (q + 1) + (xcd - r) * q) + off; }
        const int nig = WGM * nN, gid = wgid / nig, fm = gid * WGM, gsz = (nM - fm) < WGM ? (nM - fm) : WGM;
        u.pm = fm + ((wgid % nig) % gsz); u.pn = (wgid % nig) / gsz; return true;
    }
    __device__ __forceinline__ void a_ready(const Unit&) const {}
    __device__ __forceinline__ void done(const Unit&) const {}
};

__device__ __forceinline__ unsigned cvt_pk_bf16(float lo, float hi) { unsigned r; asm volatile("v_cvt_pk_bf16_f32 %0, %1, %2" : "=v"(r) : "v"(lo), "v"(hi)); return r; }
template <class Epi, class Sched, bool ALIGN_EPI = false, bool SP2 = false>
__device__ __forceinline__ void gemm_phase(PG8_LAS unsigned char* lds, const Gemm g, const Sched& S, const Epi& E, const int wave_s) {
    int lane_; asm volatile("v_mbcnt_lo_u32_b32 %0, -1, 0\n\tv_mbcnt_hi_u32_b32 %0, -1, %0" : "=v"(lane_));
    const int tid = wave_s * 64 + lane_, wid = __builtin_amdgcn_readfirstlane(tid >> 6), lane = tid & 63, wr = wid >> 2, wc = wid & 3, fr = lane & 15, fq = lane >> 4;
    const int K = g.K, nt = K / BK;
    unsigned voffA[2], voffB[2];
#pragma unroll
    for (int i = 0; i < 2; ++i) { int R, C; stage_rc(tid * 16 + i * 8192, R, C); const int Rb = Epi::PERM ? ((R & ~31) + perm32(R & 31)) : R;
        voffA[i] = (unsigned)(R * K + C) * 2u; voffB[i] = (unsigned)(Rb * K + C) * 2u; }
    const size_t kstep = (size_t)(BK * 2);
    const size_t hstep = (size_t)HALF * K * 2;
    const size_t tstep = 2 * hstep;
    const unsigned ldsw = (unsigned)wid * 1024u;
    const int aoff = lds_byte(wr * 64 + fr, fq * 8), boff = lds_byte(wc * 32 + fr, fq * 8);
#define PG8_SA(b, h) (((b) * 2 + (h)) * HTB)
#define PG8_SB(b, h) ((4 + (b) * 2 + (h)) * HTB)
#define PG8_STAGE(bufoff, gbase, voff) do { _Pragma("unroll") for (int _i = 0; _i < 2; ++_i) \
        __builtin_amdgcn_global_load_lds((const unsigned*)((const char*)(gbase) + (voff)[_i]), (PG8_LAS unsigned*)(lds + (bufoff) + ldsw + _i * 8192), 16, 0, 0); } while (0)
#define PG8_LDA(dst, b, h) do { _Pragma("unroll") for (int m = 0; m < 4; ++m) _Pragma("unroll") for (int k = 0; k < 2; ++k) dst[m][k] = *(const PG8_LAS bf16x8*)(lds + PG8_SA(b, h) + aoff + m * 2048 + k * 1024); } while (0)
#define PG8_LDB(dst, b, h) do { _Pragma("unroll") for (int n = 0; n < 2; ++n) _Pragma("unroll") for (int k = 0; k < 2; ++k) dst[n][k] = *(const PG8_LAS bf16x8*)(lds + PG8_SB(b, h) + boff + n * 2048 + k * 1024); } while (0)
#define PG8_MMA(ai, bj, At, Bt) do { __builtin_amdgcn_s_setprio(1); _Pragma("unroll") for (int m = 0; m < 4; ++m) _Pragma("unroll") for (int n = 0; n < 2; ++n) _Pragma("unroll") for (int k = 0; k < 2; ++k) \
        acc[ai][bj][m][n] = __builtin_amdgcn_mfma_f32_16x16x32_bf16(Bt[n][k], At[m][k], acc[ai][bj][m][n], 0, 0, 0); __builtin_amdgcn_s_setprio(0); } while (0)
#define PG8_WAIT_V(n) asm volatile("s_waitcnt vmcnt(" #n ")" ::: "memory")
#define PG8_WAIT_L(n) asm volatile("s_waitcnt lgkmcnt(" #n ")" ::: "memory")
#define PG8_BAR __builtin_amdgcn_s_barrier()
#define PG8_SCHED __builtin_amdgcn_sched_barrier(0)
    Unit cur, nxt; int ui = 0;
    if (!S.next(0, cur)) return;
    f32x4 acc[2][2][4][2];
#pragma unroll
    for (int a = 0; a < 2; ++a)
#pragma unroll
        for (int b = 0; b < 2; ++b)
#pragma unroll
            for (int m = 0; m < 4; ++m)
#pragma unroll
                for (int n = 0; n < 2; ++n) acc[a][b][m][n] = (f32x4){0.f, 0.f, 0.f, 0.f};
    bf16x8 At[4][2], B0[2][2], B1[2][2];
    const char* cA = (const char*)g.A + (size_t)cur.pm * tstep; const char* cB = (const char*)g.Bt + (size_t)cur.pn * tstep;
    S.a_ready(cur);
    if constexpr (SP2) {
        PG8_STAGE(PG8_SB(0, 0), cB, voffB); PG8_STAGE(PG8_SB(0, 1), cB + hstep, voffB); PG8_STAGE(PG8_SA(0, 0), cA, voffA); PG8_STAGE(PG8_SA(0, 1), cA + hstep, voffA);
        if (wr == 1) PG8_BAR;
        PG8_WAIT_V(2); PG8_BAR;
        PG8_STAGE(PG8_SB(1, 0), cB + kstep, voffB); PG8_STAGE(PG8_SA(1, 0), cA + kstep, voffA); PG8_STAGE(PG8_SB(1, 1), cB + hstep + kstep, voffB);
        PG8_WAIT_V(6); PG8_BAR;
    } else {
        PG8_STAGE(PG8_SB(0, 0), cB, voffB); PG8_STAGE(PG8_SA(0, 0), cA, voffA); PG8_STAGE(PG8_SB(0, 1), cB + hstep, voffB); PG8_STAGE(PG8_SA(0, 1), cA + hstep, voffA);
        if (wr == 1) PG8_BAR;
        PG8_WAIT_V(4); PG8_BAR;
        PG8_STAGE(PG8_SB(1, 0), cB + kstep, voffB); PG8_STAGE(PG8_SA(1, 0), cA + kstep, voffA); PG8_STAGE(PG8_SB(1, 1), cB + hstep + kstep, voffB);
        PG8_WAIT_V(6); PG8_BAR;
    }
    for (;;) {
        const bool has_next = S.next(ui + 1, nxt);
        const char* nA = has_next ? (const char*)g.A + (size_t)nxt.pm * tstep : cA; const char* nB = has_next ? (const char*)g.Bt + (size_t)nxt.pn * tstep : cB;
        for (int t = 0; t < nt; t += 2) {
            const bool last = (t == nt - 2);
            const char* a1 = cA + (size_t)(t + 1) * kstep;
            const char* a2 = last ? nA : cA + (size_t)(t + 2) * kstep; const char* b2 = last ? nB : cB + (size_t)(t + 2) * kstep;
            const char* a3 = a2 + kstep; const char* b3 = b2 + kstep;
            if (last && has_next) S.a_ready(nxt);
            if constexpr (SP2) {
            PG8_LDB(B0, 0, 0); PG8_LDB(B1, 0, 1); PG8_SCHED; PG8_LDA(At, 0, 0); PG8_STAGE(PG8_SA(1, 1), a1 + hstep, voffA);
            PG8_WAIT_V(8); PG8_WAIT_L(0); PG8_BAR; PG8_MMA(0, 0, At, B0); PG8_MMA(0, 1, At, B1); PG8_BAR; PG8_SCHED;
            PG8_LDA(At, 0, 1); PG8_STAGE(PG8_SB(0, 0), b2, voffB); PG8_STAGE(PG8_SB(0, 1), b2 + hstep, voffB); PG8_STAGE(PG8_SA(0, 0), a2, voffA);
            PG8_WAIT_V(8); PG8_WAIT_L(0); PG8_BAR; PG8_MMA(1, 0, At, B0); PG8_MMA(1, 1, At, B1); PG8_BAR; PG8_SCHED;
            PG8_LDB(B0, 1, 0); PG8_LDB(B1, 1, 1); PG8_SCHED; PG8_LDA(At, 1, 0); PG8_STAGE(PG8_SA(0, 1), a2 + hstep, voffA);
            PG8_WAIT_V(8); PG8_WAIT_L(0); PG8_BAR; PG8_MMA(0, 0, At, B0); PG8_MMA(0, 1, At, B1); PG8_BAR; PG8_SCHED;
            PG8_LDA(At, 1, 1); PG8_STAGE(PG8_SB(1, 0), b3, voffB); PG8_STAGE(PG8_SB(1, 1), b3 + hstep, voffB); PG8_STAGE(PG8_SA(1, 0), a3, voffA);
            PG8_WAIT_V(8); PG8_WAIT_L(0); PG8_BAR; PG8_MMA(1, 0, At, B0); PG8_MMA(1, 1, At, B1); PG8_BAR; PG8_SCHED;
            } else {
            PG8_LDB(B0, 0, 0); PG8_SCHED; PG8_LDA(At, 0, 0); PG8_STAGE(PG8_SA(1, 1), a1 + hstep, voffA);
            PG8_WAIT_L(8); PG8_BAR; PG8_WAIT_L(0); PG8_MMA(0, 0, At, B0); PG8_BAR; PG8_SCHED;
            PG8_LDB(B1, 0, 1); PG8_STAGE(PG8_SB(0, 0), b2, voffB);
            PG8_BAR; PG8_WAIT_L(0); PG8_MMA(0, 1, At, B1); PG8_BAR;
            PG8_LDA(At, 0, 1); PG8_STAGE(PG8_SA(0, 0), a2, voffA);
            PG8_BAR; PG8_WAIT_L(0); PG8_MMA(1, 0, At, B0); PG8_BAR; PG8_SCHED;
            PG8_STAGE(PG8_SB(0, 1), b2 + hstep, voffB);
            PG8_WAIT_V(6); PG8_BAR; PG8_MMA(1, 1, At, B1); PG8_BAR;
            PG8_LDB(B0, 1, 0); PG8_SCHED; PG8_LDA(At, 1, 0); PG8_STAGE(PG8_SA(0, 1), a2 + hstep, voffA);
            PG8_WAIT_L(8); PG8_BAR; PG8_WAIT_L(0); PG8_MMA(0, 0, At, B0); PG8_BAR; PG8_SCHED;
            PG8_LDB(B1, 1, 1); PG8_STAGE(PG8_SB(1, 0), b3, voffB);
            PG8_BAR; PG8_WAIT_L(0); PG8_MMA(0, 1, At, B1); PG8_BAR;
            PG8_LDA(At, 1, 1); PG8_STAGE(PG8_SA(1, 0), a3, voffA);
            PG8_BAR; PG8_WAIT_L(0); PG8_MMA(1, 0, At, B0); PG8_BAR; PG8_SCHED;
            PG8_STAGE(PG8_SB(1, 1), b3 + hstep, voffB);
            PG8_WAIT_V(6); PG8_BAR; PG8_MMA(1, 1, At, B1); PG8_BAR;
            }
        }
        if constexpr (ALIGN_EPI) { if (wr == 0) PG8_BAR; }
        if constexpr (!Epi::AFTER_DRAIN) { E(acc, cur, wr, wc, fr, fq); S.done(cur); }
        if (!has_next) break;
#pragma unroll
        for (int a = 0; a < 2; ++a)
#pragma unroll
            for (int b = 0; b < 2; ++b)
#pragma unroll
                for (int m = 0; m < 4; ++m)
#pragma unroll
                    for (int n = 0; n < 2; ++n) acc[a][b][m][n] = (f32x4){0.f, 0.f, 0.f, 0.f};
        cur = nxt; cA = nA; cB = nB; ++ui;
        if constexpr (ALIGN_EPI) { if (wr == 1) PG8_BAR; }
    }
    PG8_WAIT_V(0);
    if constexpr (!ALIGN_EPI) { if (wr == 0) PG8_BAR; }
    PG8_BAR;
    if constexpr (Epi::AFTER_DRAIN) { E.fused(acc, cur, wr, wc, fr, fq, lds, wid, lane); S.done(cur); }
#undef PG8_SA
#undef PG8_SB
#undef PG8_STAGE
#undef PG8_LDA
#undef PG8_LDB
#undef PG8_MMA
#undef PG8_WAIT_V
#undef PG8_WAIT_L
#undef PG8_BAR
#undef PG8_SCHED
}
}

constexpr int NB = 4, SEQ = 8192, T = NB * SEQ, DM = 1024, DFF = 4096;
constexpr int AIN = 2048, LIN = 2560, MIXW = 1536;
constexpr float EPS = 1e-6f;
constexpr float LOG2E = 1.4426950408889634f;
constexpr int NTHREADS = 512;
constexpr int LDS_BYTES = 147456;

constexpr size_t MiB = 1u << 20;
constexpr size_t WS_SS = 0;
constexpr size_t WS_BAR = 768 * 1024;
constexpr size_t WS_ROPE = 1 * MiB;
constexpr size_t WS_SUM = 3 * MiB;
constexpr size_t WS_KM = 7 * MiB;
constexpr size_t WS_VMT = 9 * MiB;
constexpr size_t WS_MEMN = 11 * MiB;
constexpr size_t WS_W_AIN = 16 * MiB, WS_W_LIN = 20 * MiB, WS_W_OUT0 = 25 * MiB, WS_W_OUT1 = 28 * MiB, WS_W_UP0 = 31 * MiB, WS_W_UP1 = 39 * MiB,
                 WS_W_DN0 = 47 * MiB, WS_W_DN1 = 55 * MiB, WS_W_MKV = 63 * MiB, WS_W_GATE = 67 * MiB;
constexpr size_t WS_VT = 68 * MiB;
constexpr size_t WS_XB = 84 * MiB;
constexpr size_t WS_CAB = 148 * MiB;
constexpr size_t WS_P = 212 * MiB;
constexpr size_t WS_MIX = 372 * MiB;
constexpr size_t WS_H = 212 * MiB;
constexpr size_t WS_END = 468 * MiB;

using pg8::bf16_t; using pg8::bf16x8; using pg8::f32x4; using pg8::u32x4; using pg8::cvt_pk_bf16;
#define LAS __attribute__((address_space(3)))
typedef float f32x16 __attribute__((ext_vector_type(16)));
typedef short s16x4 __attribute__((ext_vector_type(4)));
typedef unsigned u32x2 __attribute__((ext_vector_type(2)));

__device__ __forceinline__ float bf2f(unsigned short h) { return __uint_as_float((unsigned)h << 16); }
__device__ __forceinline__ unsigned short f2bf(float f) { unsigned u = __float_as_uint(f); return (unsigned short)((u + 0x7fffu + ((u >> 16) & 1u)) >> 16); }
__device__ __forceinline__ u32x4 pack8(f32x4 a, f32x4 b) { u32x4 w; w.x = cvt_pk_bf16(a[0], a[1]); w.y = cvt_pk_bf16(a[2], a[3]); w.z = cvt_pk_bf16(b[0], b[1]); w.w = cvt_pk_bf16(b[2], b[3]); return w; }
__device__ __forceinline__ int crow(int r, int hi) { return (r & 3) + 8 * (r >> 2) + 4 * hi; }
__device__ __forceinline__ float fast_exp2(float x) { return __builtin_amdgcn_exp2f(x); }
__device__ __forceinline__ float fast_rcp(float x) { return __builtin_amdgcn_rcpf(x); }
__device__ __forceinline__ float sigmoidf_(float z) { return fast_rcp(1.f + fast_exp2(-z * LOG2E)); }
__device__ __forceinline__ float gelu_tanh(float x) { const float y = 0.7978845608028654f * (x + 0.044715f * x * x * x); const float t = fast_exp2(2.f * LOG2E * y); return x * (1.f - fast_rcp(t + 1.f)); }
__device__ __forceinline__ int opaque_lane() { int l; asm volatile("v_mbcnt_lo_u32_b32 %0, -1, 0\n\tv_mbcnt_hi_u32_b32 %0, -1, %0" : "=v"(l)); return l; }
__device__ __forceinline__ float wave_sum(float v) {
#pragma unroll
    for (int o = 1; o < 64; o <<= 1) v += __shfl_xor(v, o);
    return v;
}

struct EpiInL0 {
    static constexpr bool PERM = true, AFTER_DRAIN = false;
    bf16_t* P; bf16_t* VT; const float* rope;
    __device__ __forceinline__ void operator()(const f32x4 (&acc)[2][2][4][2], const pg8::Unit& u, int wr, int wc, int fr, int fq) const {
        asm volatile("" : "+v"(fr), "+v"(fq));
        const int pn = u.pn;
        const bool rot = (pn < 5) && ((wc & 1) == 0);
#pragma unroll
        for (int ai = 0; ai < 2; ++ai) {
            f32x4 rp_[4][4];
            if (rot && fq < 2) {
#pragma unroll
                for (int m = 0; m < 4; ++m) { const float* rp = rope + (size_t)(u.pm * 256 + ai * 128 + wr * 64 + m * 16 + fr) * 16;
#pragma unroll
                    for (int j = 0; j < 4; ++j) rp_[m][j] = *(const f32x4*)(rp + 4 * j); }
            }
            asm volatile("" ::: "memory");
#pragma unroll
            for (int m = 0; m < 4; ++m) {
                const int row = u.pm * 256 + ai * 128 + wr * 64 + m * 16 + fr;
#pragma unroll
                for (int bj = 0; bj < 2; ++bj) {
                    const int c0 = pn * 256 + bj * 128 + wc * 32 + 8 * fq;
                    f32x4 v0 = acc[ai][bj][m][0], v1 = acc[ai][bj][m][1];
                    if (pn == 5) {
                        const int cc = c0 - 1280, kvh = cc >> 6, d = cc & 63, b = row >> 13, s = row & (SEQ - 1);
                        bf16_t* dst = VT + ((size_t)((b * 4 + kvh) * 64 + d)) * SEQ + s;
#pragma unroll
                        for (int j = 0; j < 4; ++j) { dst[(size_t)j * SEQ] = f2bf(v0[j]); dst[(size_t)(j + 4) * SEQ] = f2bf(v1[j]); }
                    } else {
                        if (rot) {
                            f32x4 p0, p1;
#pragma unroll
                            for (int j = 0; j < 4; ++j) { p0[j] = __shfl_xor(v0[j], 16); p1[j] = __shfl_xor(v1[j], 16); }
                            if (fq < 2) {
                                const f32x4 c0v = rp_[m][0], c1v = rp_[m][1], s0v = rp_[m][2], s1v = rp_[m][3];
                                const float sg = (fq == 0) ? -1.f : 1.f;
                                v0 = v0 * c0v + (p0 * s0v) * sg; v1 = v1 * c1v + (p1 * s1v) * sg;
                            }
                        }
                        *(u32x4*)(P + (size_t)row * AIN + c0) = pack8(v0, v1);
                    }
                }
                asm volatile("" ::: "memory");
            }
        }
    }
};
struct EpiMemKV {
    static constexpr bool PERM = true, AFTER_DRAIN = false;
    bf16_t* KM; bf16_t* VMT;
    __device__ __forceinline__ void operator()(const f32x4 (&acc)[2][2][4][2], const pg8::Unit& u, int wr, int wc, int fr, int fq) const {
        asm volatile("" : "+v"(fr), "+v"(fq));
#pragma unroll
        for (int ai = 0; ai < 2; ++ai)
#pragma unroll
            for (int m = 0; m < 4; ++m) {
                const int row = u.pm * 256 + ai * 128 + wr * 64 + m * 16 + fr;
#pragma unroll
                for (int bj = 0; bj < 2; ++bj) {
                    const int c = u.pn * 256 + bj * 128 + wc * 32 + 8 * fq, l = c >> 10, j0 = c & 1023;
                    const f32x4 v0 = acc[ai][bj][m][0], v1 = acc[ai][bj][m][1];
                    if (j0 < 512) { *(u32x4*)(KM + (size_t)row * 1024 + l * 512 + j0) = pack8(v0, v1); }
                    else {
                        const int jj = j0 - 512, hm = jj >> 7, d = jj & 127, b = row >> 8, mm = row & 255;
                        bf16_t* dst = VMT + ((size_t)(((l * 4 + b) * 4 + hm) * 128 + d)) * 256 + mm;
#pragma unroll
                        for (int j = 0; j < 4; ++j) { dst[(size_t)j * 256] = f2bf(v0[j]); dst[(size_t)(j + 4) * 256] = f2bf(v1[j]); }
                    }
                }
                asm volatile("" ::: "memory");
            }
    }
};
__device__ __forceinline__ void unpack8(const u32x4 w, f32x4& a, f32x4& b2) {
    a[0] = __uint_as_float(w.x << 16); a[1] = __uint_as_float(w.x & 0xffff0000u); a[2] = __uint_as_float(w.y << 16); a[3] = __uint_as_float(w.y & 0xffff0000u);
    b2[0] = __uint_as_float(w.z << 16); b2[1] = __uint_as_float(w.z & 0xffff0000u); b2[2] = __uint_as_float(w.w << 16); b2[3] = __uint_as_float(w.w & 0xffff0000u);
}
template <bool RES_BF16>
struct EpiRes {
    static constexpr bool PERM = true, AFTER_DRAIN = false;
    const void* res; bf16_t* outb; float* ss; LAS float* part;
    __device__ __forceinline__ void operator()(const f32x4 (&acc)[2][2][4][2], const pg8::Unit& u, int wr, int wc, int fr, int fq) const {
        asm volatile("" : "+v"(fr), "+v"(fq));
#pragma unroll
        for (int ai = 0; ai < 2; ++ai) {
            f32x4 pre[4][2][2]; u32x4 prb[4][2];
#pragma unroll
            for (int m = 0; m < 4; ++m)
#pragma unroll
                for (int bj = 0; bj < 2; ++bj) {
                    const size_t off = (size_t)(u.pm * 256 + ai * 128 + wr * 64 + m * 16 + fr) * DM + u.pn * 256 + bj * 128 + wc * 32 + 8 * fq;
                    if (RES_BF16) prb[m][bj] = __builtin_nontemporal_load((const u32x4*)((const bf16_t*)res + off));
                    else { pre[m][bj][0] = __builtin_nontemporal_load((const f32x4*)((const float*)res + off)); pre[m][bj][1] = __builtin_nontemporal_load((const f32x4*)((const float*)res + off + 4)); }
                }
            asm volatile("" ::: "memory");
#pragma unroll
            for (int m = 0; m < 4; ++m) {
                const int row = u.pm * 256 + ai * 128 + wr * 64 + m * 16 + fr;
                float sq = 0.f;
#pragma unroll
                for (int bj = 0; bj < 2; ++bj) {
                    const size_t off = (size_t)row * DM + u.pn * 256 + bj * 128 + wc * 32 + 8 * fq;
                    f32x4 r0, r1;
                    if (RES_BF16) unpack8(prb[m][bj], r0, r1); else { r0 = pre[m][bj][0]; r1 = pre[m][bj][1]; }
                    const f32x4 o0 = acc[ai][bj][m][0] + r0, o1 = acc[ai][bj][m][1] + r1;
                    sq += (o0[0] * o0[0] + o0[1] * o0[1]) + (o0[2] * o0[2] + o0[3] * o0[3]) + (o1[0] * o1[0] + o1[1] * o1[1]) + (o1[2] * o1[2] + o1[3] * o1[3]);
                    *(u32x4*)(outb + off) = pack8(o0, o1);
                }
                sq += __shfl_xor(sq, 16); sq += __shfl_xor(sq, 32);
                if (fq == 0) part[(ai * 128 + wr * 64 + m * 16 + fr) * 4 + wc] = sq;
            }
            asm volatile("" ::: "memory");
        }
        asm volatile("s_waitcnt lgkmcnt(0)" ::: "memory"); __builtin_amdgcn_s_barrier(); asm volatile("" ::: "memory");
        { const int lane_ = fr + 16 * fq, row = (wr * 4 + wc) * 32 + (lane_ & 31);
          if (lane_ < 32) { const f32x4 p4 = *(const LAS f32x4*)(part + row * 4); atomicAdd(ss + u.pm * 256 + row, (p4[0] + p4[1]) + (p4[2] + p4[3])); } }
    }
};
struct EpiUp {
    static constexpr bool PERM = true, AFTER_DRAIN = false;
    bf16_t* H; const float* ss;
    __device__ __forceinline__ void operator()(const f32x4 (&acc)[2][2][4][2], const pg8::Unit& u, int wr, int wc, int fr, int fq) const {
        asm volatile("" : "+v"(fr), "+v"(fq));
        float rsv[2][4];
#pragma unroll
        for (int ai = 0; ai < 2; ++ai)
#pragma unroll
            for (int m = 0; m < 4; ++m) rsv[ai][m] = ss[u.pm * 256 + ai * 128 + wr * 64 + m * 16 + fr];
#pragma unroll
        for (int ai = 0; ai < 2; ++ai)
#pragma unroll
            for (int m = 0; m < 4; ++m) rsv[ai][m] = rsqrtf(rsv[ai][m] * (1.f / DM) + EPS);
#pragma unroll
        for (int ai = 0; ai < 2; ++ai)
#pragma unroll
            for (int m = 0; m < 4; ++m) {
                const int row = u.pm * 256 + ai * 128 + wr * 64 + m * 16 + fr;
                const float rs = rsv[ai][m];
#pragma unroll
                for (int bj = 0; bj < 2; ++bj) {
                    f32x4 v0 = acc[ai][bj][m][0] * rs, v1 = acc[ai][bj][m][1] * rs;
#pragma unroll
                    for (int j = 0; j < 4; ++j) { const float a = fmaxf(v0[j], 0.f), b = fmaxf(v1[j], 0.f); v0[j] = a * a; v1[j] = b * b; }
                    *(u32x4*)(H + (size_t)row * DFF + u.pn * 256 + bj * 128 + wc * 32 + 8 * fq) = pack8(v0, v1);
                }
                asm volatile("" ::: "memory");
            }
    }
};
struct EpiInL1 {
    static constexpr bool PERM = true, AFTER_DRAIN = false;
    bf16_t* PL; const float* ss;
    __device__ __forceinline__ void operator()(const f32x4 (&acc)[2][2][4][2], const pg8::Unit& u, int wr, int wc, int fr, int fq) const {
        asm volatile("" : "+v"(fr), "+v"(fq));
        float rsv[2][4];
#pragma unroll
        for (int ai = 0; ai < 2; ++ai)
#pragma unroll
            for (int m = 0; m < 4; ++m) rsv[ai][m] = ss[u.pm * 256 + ai * 128 + wr * 64 + m * 16 + fr];
#pragma unroll
        for (int ai = 0; ai < 2; ++ai)
#pragma unroll
            for (int m = 0; m < 4; ++m) rsv[ai][m] = rsqrtf(rsv[ai][m] * (1.f / DM) + EPS);
        const bool gate = (u.pn >= 4 && u.pn < 8);
#pragma unroll
        for (int ai = 0; ai < 2; ++ai)
#pragma unroll
            for (int m = 0; m < 4; ++m) {
                const int row = u.pm * 256 + ai * 128 + wr * 64 + m * 16 + fr;
                const float rs = rsv[ai][m];
#pragma unroll
                for (int bj = 0; bj < 2; ++bj) {
                    f32x4 v0 = acc[ai][bj][m][0] * rs, v1 = acc[ai][bj][m][1] * rs;
                    if (gate) {
#pragma unroll
                        for (int j = 0; j < 4; ++j) { v0[j] = gelu_tanh(v0[j]); v1[j] = gelu_tanh(v1[j]); }
                    }
                    *(u32x4*)(PL + (size_t)row * LIN + u.pn * 256 + bj * 128 + wc * 32 + 8 * fq) = pack8(v0, v1);
                }
                asm volatile("" ::: "memory");
            }
    }
};

struct RevRounds {
    pg8::StaticOrder so; int rounds;
    __device__ __forceinline__ void init(int M, int N, int G, int c) { so.init(M, N, G, c); rounds = (so.nwg + G - 1) / G; }
    __device__ __forceinline__ bool next(int i, pg8::Unit& u) const { return i < rounds && so.next(rounds - 1 - i, u); }
    __device__ __forceinline__ void a_ready(const pg8::Unit&) const {}
    __device__ __forceinline__ void done(const pg8::Unit&) const {}
};

constexpr int TP_STR = 65, TP_BYTES = 64 * TP_STR * 4;
__device__ __forceinline__ void transpose_tile64(const float* W, int ldw, int k0, int n0, bf16_t* dst, int ldd, const float* gk, int gate_g, LAS float* scr, int lane) {
    const int l16 = lane & 15, lr = lane >> 4;
    f32x4 v[16];
#pragma unroll
    for (int i = 0; i < 16; ++i) v[i] = __builtin_nontemporal_load((const f32x4*)(W + (size_t)(k0 + 4 * i + lr) * ldw + n0 + 4 * l16));
    if (gk) {
#pragma unroll
        for (int i = 0; i < 16; ++i) v[i] = v[i] * gk[k0 + 4 * i + lr];
    }
#pragma unroll
    for (int i = 0; i < 16; ++i) { LAS float* p = scr + (4 * i + lr) * TP_STR + 4 * l16; p[0] = v[i][0]; p[1] = v[i][1]; p[2] = v[i][2]; p[3] = v[i][3]; }
    asm volatile("s_waitcnt lgkmcnt(0)" ::: "memory");
    const int c = lane & 7;
#pragma unroll
    for (int j = 0; j < 8; ++j) { const int n = (lane >> 3) + 8 * j; const LAS float* s = scr + (8 * c) * TP_STR + n;
        u32x4 o; o.x = cvt_pk_bf16(s[0 * TP_STR], s[1 * TP_STR]); o.y = cvt_pk_bf16(s[2 * TP_STR], s[3 * TP_STR]); o.z = cvt_pk_bf16(s[4 * TP_STR], s[5 * TP_STR]); o.w = cvt_pk_bf16(s[6 * TP_STR], s[7 * TP_STR]);
        const int ng = n0 + n, row = (gate_g >= 0) ? ((ng >> 5) * 128 + gate_g * 32 + (ng & 31)) : ng;
        *(u32x4*)(dst + (size_t)row * ldd + k0 + 8 * c) = o; }
    asm volatile("s_waitcnt lgkmcnt(0)" ::: "memory");
}
__device__ __forceinline__ void transpose_matrix(const float* W, int K, int N, bf16_t* WT, const float* gk, LAS float* scr, int lane, int gw, int ngw) {
    const int nblk = N / 64, nitems = (K / 64) * nblk;
    for (int it = gw; it < nitems; it += ngw) { const int kb = it / nblk, nb = it % nblk; transpose_tile64(W, N, 64 * kb, 64 * nb, WT, K, gk, -1, scr, lane); }
}
__device__ __forceinline__ void rms_row_to_bf16(const float* xrow, const float* g, bf16_t* orow, int lane) {
    const f32x4* xr = (const f32x4*)xrow + lane; const f32x4* gr = (const f32x4*)g + lane;
    f32x4 v[4]; float s = 0.f;
#pragma unroll
    for (int j = 0; j < 4; ++j) { v[j] = xr[64 * j]; s += (v[j].x * v[j].x + v[j].y * v[j].y) + (v[j].z * v[j].z + v[j].w * v[j].w); }
    const float rs = rsqrtf(wave_sum(s) * (1.f / DM) + EPS);
    u32x2* o8 = (u32x2*)orow + lane;
#pragma unroll
    for (int j = 0; j < 4; ++j) { const f32x4 gg = gr[64 * j]; u32x2 w; w.x = cvt_pk_bf16(v[j].x * rs * gg.x, v[j].y * rs * gg.y); w.y = cvt_pk_bf16(v[j].z * rs * gg.z, v[j].w * rs * gg.w); o8[64 * j] = w; }
}

__device__ __forceinline__ void rms_rows4_to_bf16(const float* xrow, const float* g, bf16_t* orow, int lane) {
    f32x4 v[4][4]; float s[4];
#pragma unroll
    for (int i = 0; i < 4; ++i)
#pragma unroll
        for (int j = 0; j < 4; ++j) v[i][j] = __builtin_nontemporal_load((const f32x4*)(xrow + (size_t)i * DM) + lane + 64 * j);
#pragma unroll
    for (int i = 0; i < 4; ++i) { s[i] = 0.f;
#pragma unroll
        for (int j = 0; j < 4; ++j) s[i] += (v[i][j].x * v[i][j].x + v[i][j].y * v[i][j].y) + (v[i][j].z * v[i][j].z + v[i][j].w * v[i][j].w); }
#pragma unroll
    for (int o = 1; o < 64; o <<= 1) {
#pragma unroll
        for (int i = 0; i < 4; ++i) s[i] += __shfl_xor(s[i], o); }
    const f32x4* gr = (const f32x4*)g + lane;
#pragma unroll
    for (int i = 0; i < 4; ++i) { const float rs = rsqrtf(s[i] * (1.f / DM) + EPS); u32x2* o8 = (u32x2*)(orow + (size_t)i * DM) + lane;
#pragma unroll
        for (int j = 0; j < 4; ++j) { const f32x4 gg = gr[64 * j]; u32x2 w; w.x = cvt_pk_bf16(v[i][j].x * rs * gg.x, v[i][j].y * rs * gg.y); w.y = cvt_pk_bf16(v[i][j].z * rs * gg.z, v[i][j].w * rs * gg.w); o8[64 * j] = w; } }
}

__device__ __forceinline__ float half_max(float x) { auto rr = __builtin_amdgcn_permlane32_swap(__float_as_uint(x), __float_as_uint(x), false, false); return fmaxf(__uint_as_float(rr[0]), __uint_as_float(rr[1])); }
__device__ __forceinline__ float half_sum(float x) { auto rr = __builtin_amdgcn_permlane32_swap(__float_as_uint(x), __float_as_uint(x), false, false); return __uint_as_float(rr[0]) + __uint_as_float(rr[1]); }
__device__ __forceinline__ float swap32(float x, int hi) { auto rr = __builtin_amdgcn_permlane32_swap(__float_as_uint(x), __float_as_uint(x), false, false); return __uint_as_float(hi ? rr[0] : rr[1]); }
template <int D, int KSTRB, int VSTRB, bool WIN, int NQ>
__device__ __forceinline__ void attn_rows(const LAS unsigned char* Kl, const LAS unsigned char* Vl, const bf16_t* qrow, size_t qgstride, int kt_lo, int kt_hi, int q0, int qi,
                                          float sinkl2, float C1, bf16_t* orow0, int ldo, int r32, int hi) {
    constexpr int ND = D / 16, NG = D / 32, NC = (NQ == 1) ? 2 : 1;
    bf16x8 qf[NQ][ND];
#pragma unroll
    for (int n = 0; n < NQ; ++n)
#pragma unroll
        for (int d0 = 0; d0 < ND; ++d0) qf[n][d0] = __builtin_nontemporal_load((const bf16x8*)(qrow + n * qgstride + d0 * 16 + hi * 8));
    float m2[NQ], l[NQ]; f32x16 o[NQ][NG];
#pragma unroll
    for (int n = 0; n < NQ; ++n) {
        m2[n] = WIN ? sinkl2 : -1e30f; l[n] = 0.f;
#pragma unroll
        for (int g = 0; g < NG; ++g)
#pragma unroll
            for (int r = 0; r < 16; ++r) o[n][g][r] = 0.f;
    }
    for (int kt = kt_lo; kt < kt_hi; ++kt) {
        if (WIN) { if (kt < 4 && kt * 32 + 31 < q0) continue; if (kt >= 8 && (kt - 8) * 32 > q0 + 32 * NQ - 1) continue; }
        const LAS unsigned char* kp = Kl + (kt * 32 + r32) * KSTRB + hi * 16;
        const int cmsk = (kt >= 8) ? -1 : 0; int thr_t[NQ];
#pragma unroll
        for (int n = 0; n < NQ; ++n) { const int qn = qi + 32 * n - 4 * hi - kt * 32; thr_t[n] = (kt < 4) ? qn : ((kt >= 8) ? ~(qn + 256) : -1000); }
        bf16x8 kf[ND];
#pragma unroll
        for (int d0 = 0; d0 < ND; ++d0) kf[d0] = *(const LAS bf16x8*)(kp + d0 * 32);
        f32x16 st[NQ][NC];
        if (WIN && ((kt < 4 && kt * 32 < q0 + 32 * NQ - 1) || (kt >= 8 && (kt - 8) * 32 + 31 > q0))) {
#pragma unroll
            for (int n = 0; n < NQ; ++n)
#pragma unroll
                for (int c = 0; c < NC; ++c)
#pragma unroll
                    for (int r = 0; r < 16; ++r) st[n][c][r] = (c == 0) ? (((crow(r, 0) ^ cmsk) >= thr_t[n]) ? 0.f : -1e30f) : 0.f;
        } else {
#pragma unroll
            for (int n = 0; n < NQ; ++n)
#pragma unroll
                for (int c = 0; c < NC; ++c)
#pragma unroll
                    for (int r = 0; r < 16; ++r) st[n][c][r] = 0.f;
        }
#pragma unroll
        for (int d0 = 0; d0 < ND; ++d0)
#pragma unroll
            for (int n = 0; n < NQ; ++n) st[n][d0 % NC] = __builtin_amdgcn_mfma_f32_32x32x16_bf16(kf[d0], qf[n][d0], st[n][d0 % NC], 0, 0, 0);
        bf16x8 pa[NQ][2];
#pragma unroll
        for (int n = 0; n < NQ; ++n) {
            float p[16]; float tmax = -1e30f;
#pragma unroll
            for (int r = 0; r < 16; ++r) {
                float s = st[n][0][r]; if (NC == 2) s += st[n][NC - 1][r];
                p[r] = s; tmax = fmaxf(tmax, s);
            }
            tmax = half_max(tmax) * C1;
            if (__any(tmax > m2[n] + 8.f)) {
                const float mn = fmaxf(m2[n], tmax), f = fast_exp2(m2[n] - mn);
                l[n] *= f; m2[n] = mn;
#pragma unroll
                for (int r = 0; r < 16; ++r) { const float fr_ = __shfl(f, crow(r, hi));
#pragma unroll
                    for (int g = 0; g < NG; ++g) o[n][g][r] *= fr_; }
            }
#pragma unroll
            for (int r = 0; r < 16; ++r) { p[r] = fast_exp2(p[r] * C1 - m2[n]); l[n] += p[r]; }
            u32x4 w0, w1; w0.x = cvt_pk_bf16(p[0], p[1]); w0.y = cvt_pk_bf16(p[2], p[3]); w0.z = cvt_pk_bf16(p[4], p[5]); w0.w = cvt_pk_bf16(p[6], p[7]);
            w1.x = cvt_pk_bf16(p[8], p[9]); w1.y = cvt_pk_bf16(p[10], p[11]); w1.z = cvt_pk_bf16(p[12], p[13]); w1.w = cvt_pk_bf16(p[14], p[15]);
            pa[n][0] = __builtin_bit_cast(bf16x8, w0); pa[n][1] = __builtin_bit_cast(bf16x8, w1);
        }
#pragma unroll
        for (int h2 = 0; h2 < 2; ++h2) {
            bf16x8 vb[NG];
#pragma unroll
            for (int g = 0; g < NG; ++g) {
                const LAS unsigned char* vp = Vl + (g * 32 + r32) * VSTRB + (kt * 32 + 16 * h2 + 4 * hi) * 2;
                const s16x4 lo = *(const LAS s16x4*)vp, hh = *(const LAS s16x4*)(vp + 16);
                vb[g] = (bf16x8){lo[0], lo[1], lo[2], lo[3], hh[0], hh[1], hh[2], hh[3]};
            }
#pragma unroll
            for (int g = 0; g < NG; ++g)
#pragma unroll
                for (int n = 0; n < NQ; ++n) o[n][g] = __builtin_amdgcn_mfma_f32_32x32x16_bf16(pa[n][h2], vb[g], o[n][g], 0, 0, 0);
        }
    }
#pragma unroll
    for (int n = 0; n < NQ; ++n) {
        float lt = half_sum(l[n]); if (WIN) lt += fast_exp2(sinkl2 - m2[n]);
        const float linv = 1.f / lt;
#pragma unroll
        for (int r = 0; r < 16; ++r) {
            const int q = crow(r, hi); const float li = __shfl(linv, q);
#pragma unroll
            for (int g = 0; g < NG; ++g) orow0[(size_t)(32 * n + q) * ldo + g * 32 + r32] = f2bf(o[n][g][r] * li);
        }
    }
}

constexpr int WK_STR = 144, WV_STR = 784, WV_OFF = 384 * WK_STR;
__device__ __forceinline__ void wattn_unit(LAS unsigned char* lds, const bf16_t* P, const bf16_t* VT, bf16_t* MIX, const float* sinks, int b, int nblk, int kvh, const int wave_s) {
    const int lane = opaque_lane(), wid = wave_s, tid = wid * 64 + lane, r32 = lane & 31, hi = lane >> 5;
    const int s0 = nblk * 128 - 128;
    {
        u32x4 kv_[6], vv_[6];
#pragma unroll
        for (int k = 0; k < 6; ++k) { const int i = tid + NTHREADS * k, row = i >> 3, ch = i & 7; int s = s0 + row; s = s < 0 ? 0 : (s > SEQ - 1 ? SEQ - 1 : s);
            kv_[k] = __builtin_nontemporal_load((const u32x4*)(P + ((size_t)(b * SEQ + s)) * AIN + 1024 + kvh * 64 + ch * 8)); }
#pragma unroll
        for (int k = 0; k < 6; ++k) { const int i = tid + NTHREADS * k, d = i / 48, ch = i % 48; int s = s0 + ch * 8; s = s < 0 ? 0 : (s > SEQ - 8 ? SEQ - 8 : s);
            vv_[k] = __builtin_nontemporal_load((const u32x4*)(VT + ((size_t)((b * 4 + kvh) * 64 + d)) * SEQ + s)); }
#pragma unroll
        for (int k = 0; k < 6; ++k) { const int i = tid + NTHREADS * k, row = i >> 3, ch = i & 7; *(LAS u32x4*)(lds + row * WK_STR + ch * 16) = kv_[k]; }
#pragma unroll
        for (int k = 0; k < 6; ++k) { const int i = tid + NTHREADS * k, d = i / 48, ch = i % 48; *(LAS u32x4*)(lds + WV_OFF + d * WV_STR + ch * 16) = vv_[k]; }
    }
    __syncthreads();
    const int hq = kvh * 4 + (wid >> 1);
    const float sinkl2 = sinks[hq] * LOG2E;
    const int kt_lo = (nblk == 0) ? 4 : 0, kt_hi = (nblk == SEQ / 128 - 1) ? 8 : 12;
    {
        const int q0 = (wid & 1) * 64, qi = q0 + r32;
        const size_t tok0 = (size_t)b * SEQ + nblk * 128 + q0;
        attn_rows<64, WK_STR, WV_STR, true, 2>(lds, lds + WV_OFF, P + (tok0 + r32) * AIN + hq * 64, (size_t)32 * AIN, kt_lo, kt_hi, q0, qi, sinkl2, 0.125f * LOG2E,
                                              MIX + tok0 * MIXW + hq * 64, MIXW, r32, hi);
    }
    __syncthreads();
}
constexpr int MK_STR = 272, MV_STR = 528, MV_OFF = 256 * MK_STR;
__device__ __forceinline__ void mattn_unit(LAS unsigned char* lds, const bf16_t* PQ, int ldq, int qcol, const bf16_t* KM, const bf16_t* VMT, bf16_t* MIX, int layer, int b, int hm, int qblk, const int wave_s) {
    const int lane = opaque_lane(), wid = wave_s, tid = wid * 64 + lane, r32 = lane & 31, hi = lane >> 5;
    {
        u32x4 kv_[8], vv_[8];
#pragma unroll
        for (int k = 0; k < 8; ++k) { const int i = tid + NTHREADS * k, row = i >> 4, ch = i & 15; kv_[k] = *(const u32x4*)(KM + ((size_t)(b * 256 + row)) * 1024 + layer * 512 + hm * 128 + ch * 8); }
#pragma unroll
        for (int k = 0; k < 8; ++k) { const int i = tid + NTHREADS * k, d = i >> 5, ch = i & 31; vv_[k] = *(const u32x4*)(VMT + ((size_t)(((layer * 4 + b) * 4 + hm) * 128 + d)) * 256 + ch * 8); }
#pragma unroll
        for (int k = 0; k < 8; ++k) { const int i = tid + NTHREADS * k, row = i >> 4, ch = i & 15; *(LAS u32x4*)(lds + row * MK_STR + ch * 16) = kv_[k]; }
#pragma unroll
        for (int k = 0; k < 8; ++k) { const int i = tid + NTHREADS * k, d = i >> 5, ch = i & 31; *(LAS u32x4*)(lds + MV_OFF + d * MV_STR + ch * 16) = vv_[k]; }
    }
    __syncthreads();
    for (int qg = 0; qg < 2; ++qg) {
        const size_t tok0 = (size_t)b * SEQ + qblk * 512 + wid * 64 + qg * 32;
        attn_rows<128, MK_STR, MV_STR, false, 1>(lds, lds + MV_OFF, PQ + (tok0 + r32) * ldq + qcol + hm * 128, 0, 0, 8, 0, 0, 0.f, 0.08838834764831845f * LOG2E,
                                                 MIX + tok0 * MIXW + 1024 + hm * 128, MIXW, r32, hi);
    }
    __syncthreads();
}

template <int DIR>
__device__ __forceinline__ void lru_tg(f32x16& a, f32x16& u, int hi, float& Pc, float& Xc) {
#pragma unroll
    for (int q = 0; q < 4; ++q) {
        const int r0 = q * 4;
        if (DIR == 0) { float c = a[r0], h = u[r0];
#pragma unroll
            for (int i = 1; i < 4; ++i) { h = a[r0 + i] * h + u[r0 + i]; c *= a[r0 + i]; a[r0 + i] = c; u[r0 + i] = h; } }
        else { float c = a[r0 + 3], h = u[r0 + 3];
#pragma unroll
            for (int i = 2; i >= 0; --i) { h = a[r0 + i] * h + u[r0 + i]; c *= a[r0 + i]; a[r0 + i] = c; u[r0 + i] = h; } }
    }
    const bool lead = (hi == DIR);
#pragma unroll
    for (int jj = 0; jj < 4; ++jj) {
        const int q = DIR ? 3 - jj : jj, rl = DIR ? q * 4 : q * 4 + 3;
        const float C = a[rl], H = u[rl];
        const float Pe = C * Pc, Xe = C * Xc + H;
        const float Pp = swap32(Pe, hi), Xp = swap32(Xe, hi);
        const float Pin = lead ? Pc : Pp, Xin = lead ? Xc : Xp;
        const float Pf = C * Pin, Xf = C * Xin + H;
        Pc = swap32(Pf, hi); Xc = swap32(Xf, hi);
#pragma unroll
        for (int i = 0; i < 4; ++i) { const int r = q * 4 + i; u[r] += a[r] * Xin; a[r] *= Pin; }
    }
}

struct LruP { const bf16_t* PL; const float* conv_w; const float* conv_b; const float* ba; const float* bx; const float* lam; const bf16_t* WG; bf16_t* CAF; bf16_t* CAB; bf16_t* MIX; float* SUM; };
constexpr int XC_STR = 272, HS_OFF = 128 * XC_STR;
constexpr int CW_OFF = HS_OFF + 65536;
__device__ __forceinline__ void lru_conv_load(const LruP& L, int uidx, int tid, bf16x8 (&xv)[7]) {
    const int blk = uidx & 7, c = (uidx >> 3) & 63, b = uidx >> 9, cbase = blk * 128 + (tid & 15) * 8, t0 = (tid >> 4) * 4;
#pragma unroll
    for (int i = 0; i < 7; ++i) { const int s = c * 128 + t0 + i - 1, sc = s < 0 ? 0 : (s > SEQ - 1 ? SEQ - 1 : s);
        xv[i] = __builtin_nontemporal_load((const bf16x8*)(L.PL + ((size_t)(b * SEQ + sc)) * LIN + cbase)); }
}
__device__ __forceinline__ void lru_conv_finish(LAS unsigned char* lds, int uidx, int tid, const bf16x8 (&xv)[7]) {
    const int c = (uidx >> 3) & 63, ch8 = tid & 15, t0 = (tid >> 4) * 4;
    const LAS float* cw = (const LAS float*)(lds + CW_OFF);
    float xf[7][8];
#pragma unroll
    for (int i = 0; i < 7; ++i) { const int s = c * 128 + t0 + i - 1; const float mk = (s >= 0 && s < SEQ) ? 1.f : 0.f;
#pragma unroll
        for (int j = 0; j < 8; ++j) xf[i][j] = bf2f((unsigned short)xv[i][j]) * mk; }
    float sum[4][8];
    { const f32x4 b0 = *(const LAS f32x4*)(cw + 512 + ch8 * 8), b1 = *(const LAS f32x4*)(cw + 512 + ch8 * 8 + 4);
#pragma unroll
      for (int k = 0; k < 4; ++k)
#pragma unroll
          for (int j = 0; j < 4; ++j) { sum[k][j] = b0[j]; sum[k][j + 4] = b1[j]; } }
#pragma unroll
    for (int tap = 0; tap < 4; ++tap) {
        const f32x4 w0 = *(const LAS f32x4*)(cw + tap * 128 + ch8 * 8), w1 = *(const LAS f32x4*)(cw + tap * 128 + ch8 * 8 + 4);
#pragma unroll
        for (int k = 0; k < 4; ++k)
#pragma unroll
            for (int j = 0; j < 4; ++j) { sum[k][j] += xf[k + tap][j] * w0[j]; sum[k][j + 4] += xf[k + tap][j + 4] * w1[j]; }
    }
#pragma unroll
    for (int k = 0; k < 4; ++k) { u32x4 o; o.x = cvt_pk_bf16(sum[k][0], sum[k][1]); o.y = cvt_pk_bf16(sum[k][2], sum[k][3]); o.z = cvt_pk_bf16(sum[k][4], sum[k][5]); o.w = cvt_pk_bf16(sum[k][6], sum[k][7]);
        *(LAS u32x4*)(lds + (t0 + k) * XC_STR + ch8 * 16) = o; }
}
__device__ __forceinline__ void lru_units(LAS unsigned char* lds, const LruP& L, int bx, int G, const int wave_s) {
    const int lane = opaque_lane(), wid = wave_s, tid = wid * 64 + lane, r32 = lane & 31, hi = lane >> 5;
    const int cg_ = wid & 3, dir = wid >> 2;
    int cur_blk = -1; float nba = 0.f, nbx = 0.f, sp16 = 0.f, spl = 0.f; bf16x8 bfr[2][8];
#pragma unroll
    for (int gi = 0; gi < 2; ++gi)
#pragma unroll
        for (int ks = 0; ks < 8; ++ks) bfr[gi][ks] = (bf16x8){0, 0, 0, 0, 0, 0, 0, 0};
    bf16x8 xv[7];
    int uidx = bx;
    if (uidx < 2048) lru_conv_load(L, uidx, tid, xv);
    for (; uidx < 2048; uidx += G) {
        const int blk = uidx & 7, c = (uidx >> 3) & 63, b = uidx >> 9, ch = blk * 128 + cg_ * 32 + r32;
        if (blk != cur_blk) {
            cur_blk = blk;
            if (tid < 160) { const int row = tid >> 5, col = (tid & 31) * 4;
                const f32x4 v = (row < 4) ? *(const f32x4*)(L.conv_w + row * 1024 + blk * 128 + col) : *(const f32x4*)(L.conv_b + blk * 128 + col);
                *(LAS f32x4*)(lds + CW_OFF + (row * 128 + col) * 4) = v; }
            nba = -L.ba[dir * 1024 + ch] * LOG2E; nbx = -L.bx[dir * 1024 + ch] * LOG2E;
            { const float xs = fast_exp2(-L.lam[dir * 1024 + ch] * LOG2E);
              const float ser = xs * (1.f - xs * (0.5f - xs * (0.33333334f - xs * 0.25f))), big = 0.6931471805599453f * __builtin_amdgcn_logf(1.f + xs);
              const float sp8 = -8.f * ((xs < 0.03f) ? ser : big); sp16 = 2.f * sp8; spl = sp8 * LOG2E; }
            const bf16_t* wrow = L.WG + ((size_t)(blk * 512 + cg_ * 128 + dir * 64 + r32)) * 128 + hi * 8;
#pragma unroll
            for (int ks = 0; ks < 8; ++ks) { bfr[0][ks] = *(const bf16x8*)(wrow + ks * 16); bfr[1][ks] = *(const bf16x8*)(wrow + 32 * 128 + ks * 16); }
            __syncthreads();
        }
        lru_conv_finish(lds, uidx, tid, xv);
        __syncthreads();
        if (uidx + G < 2048) lru_conv_load(L, uidx + G, tid, xv);
        {
            float Pc = 1.f, Xc = 0.f;
            const size_t tokbase = (size_t)b * SEQ + c * 128;
            bf16_t* ca = (dir == 0 ? L.CAF : L.CAB) + tokbase * DM + ch;
#pragma nounroll
            for (int it = 0; it < 4; ++it) {
                const int tg = dir ? 3 - it : it;
                f32x16 a, u;
#pragma unroll
                for (int r = 0; r < 16; ++r) { a[r] = 0.f; u[r] = 0.f; }
                const LAS unsigned char* xrow = lds + (tg * 32 + r32) * XC_STR + hi * 16;
                bf16x8 af[8];
#pragma unroll
                for (int ks = 0; ks < 8; ++ks) af[ks] = *(const LAS bf16x8*)(xrow + ks * 32);
#pragma unroll
                for (int ks = 0; ks < 8; ++ks) { a = __builtin_amdgcn_mfma_f32_32x32x16_bf16(af[ks], bfr[0][ks], a, 0, 0, 0); u = __builtin_amdgcn_mfma_f32_32x32x16_bf16(af[ks], bfr[1][ks], u, 0, 0, 0); }
                const LAS unsigned char* xcol = lds + (tg * 32 + 4 * hi) * XC_STR + (cg_ * 32 + r32) * 2;
                unsigned short xq[16];
#pragma unroll
                for (int r = 0; r < 16; ++r) xq[r] = *(const LAS unsigned short*)(xcol + crow(r, 0) * XC_STR);
#pragma unroll
                for (int r = 0; r < 16; ++r) {
                    const float xcv = bf2f(xq[r]);
                    const float rr = fast_rcp(1.f + fast_exp2(a[r] * (-LOG2E) + nba)), ii = fast_rcp(1.f + fast_exp2(u[r] * (-LOG2E) + nbx));
                    const float t2 = sp16 * rr;
                    const float ser = -t2 * (1.f + t2 * (0.5f + t2 * (0.16666667f + t2 * 0.041666668f)));
                    const float av = fast_exp2(spl * rr);
                    const float m1 = (t2 > -0.0625f) ? ser : (1.f - av * av);
                    a[r] = av;
                    u[r] = __builtin_amdgcn_sqrtf(m1) * ii * xcv;
                }
                if (dir == 0) lru_tg<0>(a, u, hi, Pc, Xc); else lru_tg<1>(a, u, hi, Pc, Xc);
                bf16_t* cat = ca + (size_t)(tg * 32 + 4 * hi) * DM;
                LAS unsigned short* hst = (LAS unsigned short*)(lds + HS_OFF + dir * 32768) + (tg * 32 + 4 * hi) * 128 + cg_ * 32 + r32;
#pragma unroll
                for (int r = 0; r < 16; r += 2) {
                    const unsigned pa_ = cvt_pk_bf16(a[r], a[r + 1]), pu_ = cvt_pk_bf16(u[r], u[r + 1]);
                    cat[(size_t)crow(r, 0) * DM] = (unsigned short)pa_; cat[(size_t)crow(r + 1, 0) * DM] = (unsigned short)(pa_ >> 16);
                    hst[crow(r, 0) * 128] = (unsigned short)pu_; hst[crow(r + 1, 0) * 128] = (unsigned short)(pu_ >> 16);
                }
            }
            if (hi == dir) { float* sp = L.SUM + ((size_t)(dir * 2) * 256 + (b * 64 + c)) * 1024 + ch; sp[0] = Pc; sp[(size_t)256 * 1024] = Xc; }
        }
        __syncthreads();
        {
            const size_t tokbase = (size_t)b * SEQ + c * 128;
#pragma unroll
            for (int k = 0; k < 4; ++k) {
                const int i = tid + NTHREADS * k, t = i >> 4, c8 = i & 15;
                const bf16x8 hf = *(const LAS bf16x8*)(lds + HS_OFF + (t * 128 + c8 * 8) * 2), hb = *(const LAS bf16x8*)(lds + HS_OFF + 32768 + (t * 128 + c8 * 8) * 2);
                float y[8];
#pragma unroll
                for (int j = 0; j < 8; ++j) y[j] = bf2f((unsigned short)hf[j]) + bf2f((unsigned short)hb[j]);
                u32x4 o; o.x = cvt_pk_bf16(y[0], y[1]); o.y = cvt_pk_bf16(y[2], y[3]); o.z = cvt_pk_bf16(y[4], y[5]); o.w = cvt_pk_bf16(y[6], y[7]);
                *(u32x4*)(L.MIX + (tokbase + t) * MIXW + blk * 128 + c8 * 8) = o;
            }
        }
        __syncthreads();
    }
}
__device__ __forceinline__ void lru_fix_unit(LAS unsigned char* lds, const float* SUM, const bf16_t* CAF, const bf16_t* CAB, const bf16_t* PL, bf16_t* MIX, int b, int c, const int wave_s) {
    const int tid = wave_s * 64 + opaque_lane();
    LAS float* car = (LAS float*)lds;
    {
        const int dir = tid >> 8, ch = (tid & 255) * 4;
        const float* SA = SUM + ((size_t)(dir * 2) * 256 + b * 64) * 1024 + ch; const float* SH = SA + (size_t)256 * 1024;
        f32x4 X = (f32x4){0.f, 0.f, 0.f, 0.f};
        const int n = dir ? 63 - c : c, first = dir ? 63 : 0, step = dir ? -1 : 1;
        for (int i0 = 0; i0 < n; i0 += 8) {
            f32x4 A[8], H[8];
#pragma unroll
            for (int j = 0; j < 8; ++j) { const int i = (i0 + j < n) ? i0 + j : n - 1, cc = first + step * i; A[j] = *(const f32x4*)(SA + (size_t)cc * 1024); H[j] = *(const f32x4*)(SH + (size_t)cc * 1024); }
#pragma unroll
            for (int j = 0; j < 8; ++j) if (i0 + j < n) X = A[j] * X + H[j];
        }
        *(LAS f32x4*)(car + dir * 1024 + ch) = X;
    }
    __syncthreads();
    const int ch8 = (tid & 127) * 8;
    float cf[8], cb[8];
#pragma unroll
    for (int j = 0; j < 8; ++j) { cf[j] = car[ch8 + j]; cb[j] = car[1024 + ch8 + j]; }
    for (int k0 = 0; k0 < 32; k0 += 4) {
        bf16x8 hs[4], af[4], ab[4], gt[4];
#pragma unroll
        for (int kk = 0; kk < 4; ++kk) {
            const size_t tok = (size_t)b * SEQ + c * 128 + (tid >> 7) + 4 * (k0 + kk);
            hs[kk] = __builtin_nontemporal_load((const bf16x8*)(MIX + tok * MIXW + ch8)); af[kk] = __builtin_nontemporal_load((const bf16x8*)(CAF + tok * DM + ch8)); ab[kk] = __builtin_nontemporal_load((const bf16x8*)(CAB + tok * DM + ch8)); gt[kk] = __builtin_nontemporal_load((const bf16x8*)(PL + tok * LIN + 1024 + ch8));
        }
#pragma unroll
        for (int kk = 0; kk < 4; ++kk) {
            const size_t tok = (size_t)b * SEQ + c * 128 + (tid >> 7) + 4 * (k0 + kk);
            float y[8];
#pragma unroll
            for (int j = 0; j < 8; ++j) y[j] = (bf2f((unsigned short)hs[kk][j]) + bf2f((unsigned short)af[kk][j]) * cf[j] + bf2f((unsigned short)ab[kk][j]) * cb[j]) * bf2f((unsigned short)gt[kk][j]);
            u32x4 o; o.x = cvt_pk_bf16(y[0], y[1]); o.y = cvt_pk_bf16(y[2], y[3]); o.z = cvt_pk_bf16(y[4], y[5]); o.w = cvt_pk_bf16(y[6], y[7]);
            *(u32x4*)(MIX + tok * MIXW + ch8) = o;
        }
    }
    __syncthreads();
}

#define RLX_AGENT __ATOMIC_RELAXED, __HIP_MEMORY_SCOPE_AGENT
#define XB_TMO      128
#define XB_XCNT(j)  (256  + 64 * (j))
#define XB_XSUB(j)  (1280 + 64 * (j))
#define XB_XGEN(j)  (2304 + 64 * (j))
#define XB_TOP      3328
#define XB_TOPGEN   3392
#define XCD_BAR_WORDS 3456
#define XB_SPIN_CAP (1u << 18)

__device__ __forceinline__ unsigned xb_ld(unsigned* p)              { return __hip_atomic_load(p, __ATOMIC_RELAXED, __HIP_MEMORY_SCOPE_AGENT); }
__device__ __forceinline__ unsigned xb_add(unsigned* p, unsigned v) { return __hip_atomic_fetch_add(p, v, __ATOMIC_RELAXED, __HIP_MEMORY_SCOPE_AGENT); }
__device__ __forceinline__ unsigned xb_xcc_id() { return (unsigned)__builtin_amdgcn_s_getreg((3 << 11) | 20) & 0xFu; }
#define XB_SPIN(cond, bar) do { unsigned _sp = 0; while (cond) { __builtin_amdgcn_s_sleep(1); \
    if ((++_sp & 255u) == 0u) { if (xb_ld(&(bar)[XB_TMO])) break; if (_sp > XB_SPIN_CAP) { atomicAdd(&(bar)[XB_TMO], 1u); break; } } } } while (0)

struct XcdBarrier {
    unsigned* bar; unsigned x;
    volatile LAS unsigned* st;
};

__device__ __forceinline__ XcdBarrier xcd_barrier_post(unsigned* bar, volatile LAS unsigned* st) {
    XcdBarrier b; b.bar = bar; b.x = xb_xcc_id(); b.st = st;
    if (threadIdx.x == 0) (void)xb_add(&bar[XB_XCNT(b.x)], 1u);
    return b;
}
__device__ __forceinline__ void xcd_barrier_complete(unsigned* bar, unsigned x, unsigned& nloc, unsigned& nx) {
    const unsigned G = gridDim.x * gridDim.y * gridDim.z;
    unsigned sum, cnt, mine, sp = 0u;
    for (;;) {
        sum = 0u; cnt = 0u; mine = 0u;
#pragma unroll
        for (unsigned j = 0; j < 16; ++j) { const unsigned c = xb_ld(&bar[XB_XCNT(j)]); sum += c; cnt += (c > 0u) ? 1u : 0u; mine = (j == x) ? c : mine; }
        if (sum == G) break;
        __builtin_amdgcn_s_sleep(1);
        if ((++sp & 255u) == 0u) { if (xb_ld(&bar[XB_TMO])) break; if (sp > XB_SPIN_CAP) { atomicAdd(&bar[XB_TMO], 1u); break; } }
    }
    nloc = mine > 0u ? mine : 1u; nx = cnt > 0u ? cnt : 1u;
}

__device__ __forceinline__ void xcd_barrier(const XcdBarrier& b) {
    asm volatile("s_waitcnt vmcnt(0)" ::: "memory");
    __syncthreads();
    if (threadIdx.x == 0) {
        unsigned* bar = b.bar;
        __builtin_amdgcn_s_waitcnt(0);
        unsigned nloc = b.st[0], nx = b.st[1];
        if (nloc == 0u) { xcd_barrier_complete(bar, b.x, nloc, nx); b.st[0] = nloc; b.st[1] = nx; }
        const unsigned old = xb_add(&bar[XB_XSUB(b.x)], 1u);
        const unsigned gen = old / nloc;
        if (old + 1u == (gen + 1u) * nloc) {
            __builtin_amdgcn_fence(__ATOMIC_RELEASE, "agent");
            asm volatile("s_waitcnt vmcnt(0)" ::: "memory");
            const unsigned og = xb_add(&bar[XB_TOP], 1u);
            const unsigned tg = og / nx;
            if (og + 1u == (tg + 1u) * nx) xb_add(&bar[XB_TOPGEN], 1u);
            else XB_SPIN(xb_ld(&bar[XB_TOPGEN]) == tg, bar);
            __builtin_amdgcn_fence(__ATOMIC_ACQUIRE, "agent");
            xb_add(&bar[XB_XGEN(b.x)], 1u);
            asm volatile("s_waitcnt vmcnt(0)" ::: "memory");
        } else {
            XB_SPIN(xb_ld(&bar[XB_XGEN(b.x)]) == gen, bar);
            __builtin_amdgcn_fence(__ATOMIC_ACQUIRE, "agent");
            asm volatile("s_waitcnt vmcnt(0)" ::: "memory");
        }
    }
    __syncthreads();
}

struct Args { const void* in[21]; float* out; unsigned char* ws; int ph_lo, ph_hi; };
constexpr int N_PHASES = 13;
#ifndef DUP_PHASE
#define DUP_PHASE (-1)
#endif

#define REPS(k) for (int rep_ = 0; rep_ < (((k) == DUP_PHASE) ? 2 : 1); ++rep_)

__global__ void __launch_bounds__(NTHREADS, 2) fwd_kernel(Args args) {
    extern __shared__ __attribute__((aligned(16))) unsigned char lds_raw[];
    LAS unsigned char* lds = (LAS unsigned char*)lds_raw;
    cg::grid_group grid = cg::this_grid();
    const int wave = __builtin_amdgcn_readfirstlane(threadIdx.x >> 6);
    const int G = gridDim.x, bx = blockIdx.x;
    const int gw = bx * 8 + wave, ngw = G * 8;
    const int lo = args.ph_lo, hi_ = args.ph_hi;
#define IN(k) (lo <= (k) && (k) < hi_)
#define SEAM(k) do { if (IN(k) && IN((k) + 1)) xcd_barrier(bar); } while (0)
    const float* x_in = (const float*)args.in[0]; const float* mem = (const float*)args.in[1]; const int* positions = (const int*)args.in[2];
    const float* mix_norm = (const float*)args.in[3]; const float* mlp_norm = (const float*)args.in[4]; const float* mem_norm = (const float*)args.in[5]; const float* final_norm = (const float*)args.in[6];
    const float* w_mem_kv = (const float*)args.in[7]; const float* w_out = (const float*)args.in[8]; const float* w_up = (const float*)args.in[9]; const float* w_down = (const float*)args.in[10];
    const float* attn_w_in = (const float*)args.in[11]; const float* attn_sinks = (const float*)args.in[12]; const float* lru_w_in = (const float*)args.in[13];
    const float* lru_conv_w = (const float*)args.in[14]; const float* lru_conv_b = (const float*)args.in[15]; const float* lru_wa = (const float*)args.in[16]; const float* lru_ba = (const float*)args.in[17];
    const float* lru_wx = (const float*)args.in[18]; const float* lru_bx = (const float*)args.in[19]; const float* lru_lambda = (const float*)args.in[20];
    unsigned char* ws = args.ws; float* X = args.out;
    unsigned* barw = (unsigned*)(ws + WS_BAR);
    volatile LAS unsigned* bst = (volatile LAS unsigned*)(lds + LDS_BYTES - 64);
    if (threadIdx.x == 0) { bst[0] = 0u; bst[1] = 0u; }
    __syncthreads();
    XcdBarrier bar; bar.bar = barw; bar.x = 0; bar.st = bst;
    if (args.ph_lo < 0) grid.sync();
    if (args.ph_hi - args.ph_lo > 1) bar = xcd_barrier_post(barw, bst);
    float* SS = (float*)(ws + WS_SS); float* ROPE = (float*)(ws + WS_ROPE); float* SUM = (float*)(ws + WS_SUM);
    bf16_t* KM = (bf16_t*)(ws + WS_KM); bf16_t* VMT = (bf16_t*)(ws + WS_VMT); bf16_t* MEMN = (bf16_t*)(ws + WS_MEMN);
    bf16_t* W_AIN = (bf16_t*)(ws + WS_W_AIN); bf16_t* W_LIN = (bf16_t*)(ws + WS_W_LIN); bf16_t* W_MKV = (bf16_t*)(ws + WS_W_MKV); bf16_t* W_GATE = (bf16_t*)(ws + WS_W_GATE);
    bf16_t* VT = (bf16_t*)(ws + WS_VT); bf16_t* XB = (bf16_t*)(ws + WS_XB); bf16_t* CAB = (bf16_t*)(ws + WS_CAB); bf16_t* PB = (bf16_t*)(ws + WS_P); bf16_t* MIX = (bf16_t*)(ws + WS_MIX); bf16_t* HB = (bf16_t*)(ws + WS_H);

    if (IN(0)) REPS(0) {
        const int lane = opaque_lane(), tid = wave * 64 + lane;
        for (int i = bx * NTHREADS + tid; i < 4 * T; i += G * NTHREADS) SS[i] = 0.f;
        for (int i = bx * NTHREADS + tid; i < T * 8; i += G * NTHREADS) {
            const int tok = i >> 3, f = i & 7;
            const float invf = (f == 0) ? 1.0f : (f == 1) ? 0.1939227432012558f : (f == 2) ? 0.03760603070259094f : (f == 3) ? 0.007292664609849453f : (f == 4) ? 0.0014142135623842478f
                             : (f == 5) ? 0.00027424818836152554f : (f == 6) ? 5.3182957344688475e-05f : 1.0313385246263351e-05f;
            const float ang = (float)positions[tok] * invf; float sn, cs; sincosf(ang, &sn, &cs);
            ROPE[(size_t)tok * 16 + f] = cs; ROPE[(size_t)tok * 16 + 8 + f] = sn;
        }
        LAS float* scr = (LAS float*)(lds + wave * TP_BYTES);
        {
            constexpr int I_AIN = (DM / 64) * (AIN / 64), I_LIN = (DM / 64) * (LIN / 64), I_OUT = (MIXW / 64) * (DM / 64), I_UP = (DM / 64) * (DFF / 64), I_DN = (DFF / 64) * (DM / 64), I_MKV = (DM / 64) * (1024 / 64), I_GATE = 128;
            constexpr int I_TOTAL = I_AIN + I_LIN + 2 * (I_OUT + I_UP + I_DN + I_MKV) + I_GATE;
            for (int it = gw; it < I_TOTAL; it += ngw) {
                int r = it;
                if (r < I_AIN) { transpose_tile64(attn_w_in, AIN, 64 * (r / (AIN / 64)), 64 * (r % (AIN / 64)), W_AIN, DM, nullptr, -1, scr, lane); continue; } r -= I_AIN;
                if (r < I_LIN) { transpose_tile64(lru_w_in, LIN, 64 * (r / (LIN / 64)), 64 * (r % (LIN / 64)), W_LIN, DM, mix_norm + DM, -1, scr, lane); continue; } r -= I_LIN;
                bool done = false;
#pragma unroll
                for (int l = 0; l < 2; ++l) {
                    if (done) break;
                    if (r < I_OUT) { transpose_tile64(w_out + (size_t)l * MIXW * DM, DM, 64 * (r / (DM / 64)), 64 * (r % (DM / 64)), (bf16_t*)(ws + (l ? WS_W_OUT1 : WS_W_OUT0)), MIXW, nullptr, -1, scr, lane); done = true; break; } r -= I_OUT;
                    if (r < I_UP) { transpose_tile64(w_up + (size_t)l * DM * DFF, DFF, 64 * (r / (DFF / 64)), 64 * (r % (DFF / 64)), (bf16_t*)(ws + (l ? WS_W_UP1 : WS_W_UP0)), DM, mlp_norm + l * DM, -1, scr, lane); done = true; break; } r -= I_UP;
                    if (r < I_DN) { transpose_tile64(w_down + (size_t)l * DFF * DM, DM, 64 * (r / (DM / 64)), 64 * (r % (DM / 64)), (bf16_t*)(ws + (l ? WS_W_DN1 : WS_W_DN0)), DFF, nullptr, -1, scr, lane); done = true; break; } r -= I_DN;
                    if (r < I_MKV) { transpose_tile64(w_mem_kv + (size_t)l * DM * 1024, 1024, 64 * (r / 16), 64 * (r % 16), W_MKV + (size_t)l * 1024 * DM, DM, nullptr, -1, scr, lane); done = true; break; } r -= I_MKV;
                }
                if (done) continue;
                {
                    const int n = r >> 4, g = (r >> 2) & 3, kb = (r >> 1) & 1, nb = r & 1;
                    const float* W = ((g & 1) ? lru_wx : lru_wa) + ((size_t)((g >> 1) * 8 + n)) * 128 * 128;
                    transpose_tile64(W, 128, 64 * kb, 64 * nb, W_GATE + (size_t)n * 512 * 128, 128, nullptr, g, scr, lane);
                }
            }
        }
        for (int m = gw; m < 1024; m += ngw) rms_row_to_bf16(mem + (size_t)m * DM, mem_norm, MEMN + (size_t)m * DM, lane);
        for (int m = gw * 4; m < T; m += ngw * 4) rms_rows4_to_bf16(x_in + (size_t)m * DM, mix_norm, XB + (size_t)m * DM, lane);
    }
    SEAM(0);
#pragma nounroll
    for (int layer = 0; layer < 2; ++layer) {
        const int pb = layer ? 6 : 1;
        if (IN(pb)) REPS(pb) {
            if (layer == 0) {
                { pg8::Gemm g{XB, W_AIN, T, AIN, DM}; pg8::StaticOrder S; S.init(T, AIN, G, bx); EpiInL0 E{PB, VT, ROPE};

#ifndef NO_EpiInL0
pg8::gemm_phase<EpiInL0, pg8::StaticOrder, true, true>(lds, g, S, E, wave);
#endif
 }
                { pg8::Gemm g{MEMN, W_MKV, 1024, 2048, DM}; pg8::StaticOrder S; S.init(1024, 2048, G, bx); EpiMemKV E{KM, VMT};

#ifndef NO_EpiMemKV
pg8::gemm_phase<EpiMemKV, pg8::StaticOrder, true, true>(lds, g, S, E, wave);
#endif
 }
            } else {
                pg8::Gemm g{XB, W_LIN, T, LIN, DM}; pg8::StaticOrder S; S.init(T, LIN, G, bx); EpiInL1 E{PB, SS + 1 * T};

#ifndef NO_EpiInL1
pg8::gemm_phase<EpiInL1, pg8::StaticOrder, true, true>(lds, g, S, E, wave);
#endif

            }
        }
        SEAM(pb);
        if (IN(pb + 1)) REPS(pb + 1) {
            if (layer == 0) {
                for (int uidx = bx; uidx < 1024 + 256; uidx += G) {
                    if (uidx < 1024) { const int kvh = uidx & 3, nblk = (uidx >> 2) & 63, b = uidx >> 8;
#ifndef NO_WATTN
 wattn_unit(lds, PB, VT, MIX, attn_sinks, b, nblk, kvh, wave);
#endif
 }
                    else { const int v = uidx - 1024, hm = v & 3, qblk = (v >> 2) & 15, b = v >> 6;
#ifndef NO_MATTN
 mattn_unit(lds, PB, AIN, 1536, KM, VMT, MIX, 0, b, hm, qblk, wave);
#endif
 }
                }
            } else {
                LruP L{PB, lru_conv_w, lru_conv_b, lru_ba, lru_bx, lru_lambda, W_GATE, (bf16_t*)X, CAB, MIX, SUM};
                lru_units(lds, L, bx, G, wave);
                for (int v = bx; v < 256; v += G) { const int hm = v & 3, qblk = (v >> 2) & 15, b = v >> 6; mattn_unit(lds, PB, LIN, 2048, KM, VMT, MIX, 1, b, hm, qblk, wave); }
            }
        }
        SEAM(pb + 1);
        if (layer == 1) {
            if (IN(8)) { for (int uidx = bx; uidx < 256; uidx += G) lru_fix_unit(lds, SUM, (const bf16_t*)X, CAB, PB, MIX, uidx >> 6, uidx & 63, wave); }
            SEAM(8);
        }
        const int po = layer ? 9 : 3;
        if (IN(po)) {
            pg8::Gemm g{MIX, (const bf16_t*)(ws + (layer ? WS_W_OUT1 : WS_W_OUT0)), T, DM, MIXW}; pg8::StaticOrder S; S.init(T, DM, G, bx);
            if (layer == 0) { EpiRes<false> E{x_in, XB, SS + 0 * T, (LAS float*)(lds + pg8::STAGE_BYTES)}; pg8::gemm_phase<EpiRes<false>, pg8::StaticOrder, true, true>(lds, g, S, E, wave); }
            else { EpiRes<true> E{XB, XB, SS + 2 * T, (LAS float*)(lds + pg8::STAGE_BYTES)}; pg8::gemm_phase<EpiRes<true>, pg8::StaticOrder, true, true>(lds, g, S, E, wave); }
        }
        SEAM(po);
        if (IN(po + 1)) REPS(po + 1) {
            pg8::Gemm g{XB, (const bf16_t*)(ws + (layer ? WS_W_UP1 : WS_W_UP0)), T, DFF, DM}; pg8::StaticOrder S; S.init(T, DFF, G, bx);
            EpiUp E{HB, SS + (layer ? 2 : 0) * T};

#ifndef NO_EpiUp
pg8::gemm_phase<EpiUp, pg8::StaticOrder, true, true>(lds, g, S, E, wave);
#endif

        }
        SEAM(po + 1);
        if (IN(po + 2)) {
            pg8::Gemm g{HB, (const bf16_t*)(ws + (layer ? WS_W_DN1 : WS_W_DN0)), T, DM, DFF}; RevRounds S; S.init(T, DM, G, bx);
            EpiRes<true> E{XB, XB, SS + (layer ? 3 : 1) * T, (LAS float*)(lds + pg8::STAGE_BYTES)};
            pg8::gemm_phase<EpiRes<true>, RevRounds, true, true>(lds, g, S, E, wave);
        }
        SEAM(po + 2);
    }
    if (IN(12)) {
        const int lane = opaque_lane();
        const float* ss = SS + 3 * T;
        f32x4 gg[2][2];
#pragma unroll
        for (int j = 0; j < 2; ++j) { gg[j][0] = *(const f32x4*)(final_norm + (lane + 64 * j) * 8); gg[j][1] = *(const f32x4*)(final_norm + (lane + 64 * j) * 8 + 4); }
        for (int m0 = gw * 4; m0 < T; m0 += ngw * 4) {
            u32x4 w[4][2]; float rs[4];
#pragma unroll
            for (int i = 0; i < 4; ++i) { rs[i] = rsqrtf(ss[m0 + i] * (1.f / DM) + EPS);
#pragma unroll
                for (int j = 0; j < 2; ++j) w[i][j] = __builtin_nontemporal_load((const u32x4*)(XB + (size_t)(m0 + i) * DM + (lane + 64 * j) * 8)); }
#pragma unroll
            for (int i = 0; i < 4; ++i)
#pragma unroll
                for (int j = 0; j < 2; ++j) { f32x4 a0, a1; unpack8(w[i][j], a0, a1); float* op = X + (size_t)(m0 + i) * DM + (lane + 64 * j) * 8;
                    __builtin_nontemporal_store(a0 * rs[i] * gg[j][0], (f32x4*)op); __builtin_nontemporal_store(a1 * rs[i] * gg[j][1], (f32x4*)(op + 4)); }
        }
    }
#undef IN
#undef SEAM
}

#ifndef MK_N_LAUNCHES
#define MK_N_LAUNCHES 1
#endif
extern "C" void kernel_launch(void* const* d_in, const int* in_sizes, int n_in, void* d_out, int out_size, void* d_ws, size_t ws_size, hipStream_t stream) {
    static int grid = 0;
    if (grid == 0) {
        if (n_in != 21 || in_sizes[0] != T * DM || out_size != T * DM || ws_size < WS_END) {
            fprintf(stderr, "kernel_launch: unexpected problem: n_in %d in0 %d out %d ws %zu (need %zu)\n", n_in, n_in > 0 ? in_sizes[0] : -1, out_size, ws_size, (size_t)WS_END); grid = -1; return; }
        int dev = 0, cus = 0, per_cu = 0;
        if (hipGetDevice(&dev) != hipSuccess || hipDeviceGetAttribute(&cus, hipDeviceAttributeMultiprocessorCount, dev) != hipSuccess) { fprintf(stderr, "kernel_launch: device query failed\n"); grid = -1; return; }
        if (hipFuncSetAttribute((const void*)fwd_kernel, hipFuncAttributeMaxDynamicSharedMemorySize, LDS_BYTES) != hipSuccess) { fprintf(stderr, "kernel_launch: hipFuncSetAttribute failed\n"); grid = -1; return; }
        if (hipOccupancyMaxActiveBlocksPerMultiprocessor(&per_cu, (const void*)fwd_kernel, NTHREADS, LDS_BYTES) != hipSuccess || per_cu < 1) { fprintf(stderr, "kernel_launch: occupancy query gave %d\n", per_cu); per_cu = 1; }
        (void)hipGetLastError();
        grid = cus;
        fprintf(stderr, "kernel_launch: grid %d (cus %d, per_cu %d)\n", grid, cus, per_cu);
    }
    if (grid < 0) return;
    Args a{};
    for (int i = 0; i < 21; ++i) a.in[i] = d_in[i];
    a.out = (float*)d_out; a.ws = (unsigned char*)d_ws;
#if MK_N_LAUNCHES == 1
    a.ph_lo = 0; a.ph_hi = N_PHASES;
    if (hipMemsetAsync((char*)d_ws + WS_BAR, 0, XCD_BAR_WORDS * 4, stream) != hipSuccess) { fprintf(stderr, "kernel_launch: memset of the barrier words failed\n"); return; }
    void* kargs[] = {&a};
    hipError_t e = hipLaunchCooperativeKernel((const void*)fwd_kernel, dim3(grid), dim3(NTHREADS), kargs, LDS_BYTES, stream);
    if (e != hipSuccess) fprintf(stderr, "kernel_launch: cooperative launch failed: %s (grid %d)\n", hipGetErrorString(e), grid);
#else
    for (int p = 0; p < N_PHASES; ++p) {
        a.ph_lo = p; a.ph_hi = p + 1;
        hipLaunchKernelGGL(fwd_kernel, dim3(grid), dim3(NTHREADS), LDS_BYTES, stream, a);
    }
#endif
}
```
